# Optimizing an MI355X kernel written in HIP

```python
import math
import jax
import jax.numpy as jnp
from jax import lax
import numpy as np

D_MODEL = 2048
BATCH = 1
SEQ = 8192
DEPTH = 4

GRID_W = 64
CTX_LEN = 256
D_MIX = D_MODEL
LRU_W = D_MIX // 2
LRU_HEADS = 4
LRU_HEAD_DIM = LRU_W // LRU_HEADS
LRU_CONV = 4
LRU_C = 8.0
HY_W = D_MIX - LRU_W
HY_CONV = 3
HY_EMB = 33
HY_BANDS = (HY_EMB - 1) // 2
HY_ORDER_DIM = 64
HY_TARGET = 1e-2
HY_FAST_DECAY_PCT = 0.3
HY_SLOW_DECAY_PCT = 1.5
HY_MAX_DECAY = math.log(HY_TARGET) / HY_FAST_DECAY_PCT
HY_MIN_DECAY = math.log(HY_TARGET) / HY_SLOW_DECAY_PCT
IN_COLS = 2 * LRU_W + 3 * HY_W
D_FF = 5632
N_MOD = 9
EPS = 1e-6

kernel_name = 'hybrid_rglru_hyena_macaron_dit'


def rms_norm(x, g):
    xf = x.astype(jnp.float32)
    y = xf * lax.rsqrt(jnp.mean(xf * xf, axis=-1, keepdims=True) + EPS)
    return (y * g.astype(jnp.float32)).astype(x.dtype)


def modulate(x, g, shift, scale):
    return rms_norm(x, g) * (1 + scale) + shift


def swiglu(u, wg, wu, wd):
    return (jax.nn.silu(u @ wg) * (u @ wu)) @ wd


def ffn_sublayer(h, mod, g, wg, wu, wd):
    shift, scale, gate = mod
    return h + 0.5 * gate * swiglu(modulate(h, g, shift, scale), wg, wu, wd)


def dw_conv(u, w, b):
    K = w.shape[0]
    L = u.shape[1]
    left = (K - 1) // 2
    up = jnp.pad(u, ((0, 0), (left, K - 1 - left), (0, 0)))
    out = b
    for k in range(K):
        out = out + up[:, k:k + L] * w[k]
    return out


def to_col_major(u):
    B, N, C = u.shape
    rows = N // GRID_W
    return u.reshape(B, rows, GRID_W, C).transpose(0, 2, 1, 3).reshape(B, N, C)


def from_col_major(u):
    B, N, C = u.shape
    rows = N // GRID_W
    return u.reshape(B, GRID_W, rows, C).transpose(0, 2, 1, 3).reshape(B, N, C)


def _lin_combine(left, right):
    a1, b1 = left
    a2, b2 = right
    return a1 * a2, a2 * b1 + b2


def rglru_coeffs(xc, wa, ba, wx, bx, lam):
    B, L, _ = xc.shape
    xf = xc.astype(jnp.float32)
    xh = xf.reshape(B, L, LRU_HEADS, LRU_HEAD_DIM)
    r = jax.nn.sigmoid(jnp.einsum('blhd,hde->blhe', xh, wa.astype(jnp.float32)).reshape(B, L, LRU_W) + ba)
    i = jax.nn.sigmoid(jnp.einsum('blhd,hde->blhe', xh, wx.astype(jnp.float32)).reshape(B, L, LRU_W) + bx)
    log_a = -LRU_C * r * jax.nn.softplus(-lam.astype(jnp.float32))
    a = jnp.exp(log_a)
    b = jnp.sqrt(-jnp.expm1(2.0 * log_a)) * (i * xf)
    return a, b


def linear_scan(a, b, h0, reverse):
    A, Bc = lax.associative_scan(_lin_combine, (a, b), axis=1, reverse=reverse)
    if h0 is None:
        return Bc
    return A * h0[:, None, :] + Bc


def bidir_rglru(cv_ctx, cv_lat, wa, ba, wx, bx, lam, need_ctx):
    h_lat = []
    h_ctx = []
    for d in range(2):
        rev = d == 1
        a_c, b_c = rglru_coeffs(cv_ctx, wa[d], ba[d], wx[d], bx[d], lam[d])
        hc = linear_scan(a_c, b_c, None, rev)
        h0 = hc[:, 0] if rev else hc[:, -1]
        a_l, b_l = rglru_coeffs(cv_lat, wa[d], ba[d], wx[d], bx[d], lam[d])
        h_lat.append(linear_scan(a_l, b_l, h0, rev))
        h_ctx.append(hc)
    lat = h_lat[0] + h_lat[1]
    ctx = (h_ctx[0] + h_ctx[1]) if need_ctx else None
    return lat, ctx


def hyena_filters(L, w1, b1, w2, b2, w3, b3, w4, b4, freq):
    f32 = jnp.float32
    t = jnp.linspace(0.0, 1.0, L, dtype=f32)[:, None]
    w = 2.0 * math.pi * jnp.arange(L, dtype=f32) / L
    f = jnp.linspace(1e-4, HY_BANDS - 1, HY_BANDS, dtype=f32)
    ang = w[:, None] * f[None, :]
    z = jnp.concatenate([t, jnp.cos(ang), -jnp.sin(ang)], axis=-1)
    fr = freq.astype(f32)
    h = jnp.sin(fr * (z @ w1.astype(f32) + b1.astype(f32)))
    h = jnp.sin(fr * (h @ w2.astype(f32) + b2.astype(f32)))
    h = jnp.sin(fr * (h @ w3.astype(f32) + b3.astype(f32)))
    k = h @ w4.astype(f32) + b4.astype(f32)
    deltas = jnp.abs(jnp.linspace(HY_MIN_DECAY, HY_MAX_DECAY, HY_W, dtype=f32))
    decay = jnp.exp(-t * deltas[None, :])
    k_fwd = k[:, :HY_W] * decay
    k_bwd = k[:, HY_W:] * decay
    k_full = jnp.concatenate([k_fwd, jnp.zeros((1, HY_W), f32), k_bwd[:0:-1]], axis=0)
    return k_full / jnp.sum(jnp.abs(k_full), axis=0, keepdims=True)


def long_conv(v, k_full, bias):
    L = v.shape[1]
    vf = v.astype(jnp.float32)
    V = jnp.fft.rfft(vf, n=2 * L, axis=1)
    K = jnp.fft.rfft(k_full, n=2 * L, axis=0)
    y = jnp.fft.irfft(V * K[None], n=2 * L, axis=1)[:, :L]
    return (y + vf * bias.astype(jnp.float32)).astype(v.dtype)


def hyena(proj, conv_w, conv_b, k_full, bias):
    z = dw_conv(proj, conv_w, conv_b)
    x0, x1, v = jnp.split(z, 3, axis=-1)
    return long_conv(v * x1, k_full, bias) * x0


def merge_groups(h_lru, yr, y_hy, out_g, w_out):
    lru = h_lru.astype(yr.dtype) * jax.nn.gelu(yr)
    lru = rms_norm(lru, out_g[:LRU_W])
    hy = rms_norm(y_hy, out_g[LRU_W:])
    return jnp.concatenate([lru, hy], axis=-1) @ w_out


def setup_inputs(seed: int = 0) -> dict:
    key = jax.random.key(seed)
    keys = jax.random.split(key, 33)
    f32 = jnp.float32

    def nrm(i, shape, scale):
        return jax.random.normal(keys[i], shape, f32) * scale

    lam_u = jax.random.uniform(keys[19], (DEPTH, 2, LRU_W), f32, 0.9, 0.999)
    lam_s = lam_u ** (1.0 / LRU_C)
    lam = jnp.log(lam_s) - jnp.log1p(-lam_s)
    return {
        'x': nrm(0, (BATCH, SEQ, D_MODEL), 1.0),
        'c': nrm(1, (BATCH, D_MODEL), 1.0),
        'ctx': nrm(2, (BATCH, CTX_LEN, D_MODEL), 1.0),
        'c_ctx': nrm(3, (D_MODEL,), 1.0),
        'ada_w': nrm(4, (DEPTH, D_MODEL, N_MOD * D_MODEL), 0.5 * D_MODEL ** -0.5),
        'ada_b': nrm(5, (DEPTH, N_MOD * D_MODEL), 0.02),
        'norm_g': 1.0 + nrm(6, (DEPTH, 3, D_MODEL), 0.02),
        'ffn_wg': nrm(7, (DEPTH, 2, D_MODEL, D_FF), D_MODEL ** -0.5),
        'ffn_wu': nrm(8, (DEPTH, 2, D_MODEL, D_FF), D_MODEL ** -0.5),
        'ffn_wd': nrm(9, (DEPTH, 2, D_FF, D_MODEL), D_FF ** -0.5),
        'w_in': nrm(10, (DEPTH, D_MODEL, IN_COLS), D_MODEL ** -0.5),
        'w_out': nrm(11, (DEPTH, D_MIX, D_MODEL), D_MIX ** -0.5),
        'out_g': 1.0 + nrm(12, (DEPTH, D_MIX), 0.02),
        'lru_conv_w': nrm(13, (DEPTH, LRU_CONV, LRU_W), LRU_CONV ** -0.5),
        'lru_conv_b': nrm(14, (DEPTH, LRU_W), 0.02),
        'lru_wa': nrm(15, (DEPTH, 2, LRU_HEADS, LRU_HEAD_DIM, LRU_HEAD_DIM), LRU_HEAD_DIM ** -0.5),
        'lru_ba': nrm(16, (DEPTH, 2, LRU_W), 0.02),
        'lru_wx': nrm(17, (DEPTH, 2, LRU_HEADS, LRU_HEAD_DIM, LRU_HEAD_DIM), LRU_HEAD_DIM ** -0.5),
        'lru_bx': nrm(18, (DEPTH, 2, LRU_W), 0.02),
        'lru_lam': lam,
        'hy_conv_w': nrm(20, (DEPTH, HY_CONV, 3 * HY_W), HY_CONV ** -0.5),
        'hy_conv_b': nrm(21, (DEPTH, 3 * HY_W), 0.02),
        'hy_bias': nrm(22, (DEPTH, HY_W), 1.0),
        'filt_w1': nrm(23, (DEPTH, HY_EMB, HY_ORDER_DIM), HY_EMB ** -0.5),
        'filt_b1': nrm(24, (DEPTH, HY_ORDER_DIM), 0.1),
        'filt_w2': nrm(25, (DEPTH, HY_ORDER_DIM, HY_ORDER_DIM), HY_ORDER_DIM ** -0.5),
        'filt_b2': nrm(26, (DEPTH, HY_ORDER_DIM), 0.1),
        'filt_w3': nrm(27, (DEPTH, HY_ORDER_DIM, HY_ORDER_DIM), HY_ORDER_DIM ** -0.5),
        'filt_b3': nrm(28, (DEPTH, HY_ORDER_DIM), 0.1),
        'filt_w4': nrm(29, (DEPTH, HY_ORDER_DIM, 2 * HY_W), HY_ORDER_DIM ** -0.5),
        'filt_b4': nrm(30, (DEPTH, 2 * HY_W), 0.1),
        'filt_freq': 1.0 + nrm(31, (DEPTH, HY_ORDER_DIM), 0.02),
        'final_g': 1.0 + nrm(32, (D_MODEL,), 0.02),
    }


def reference(x, c, ctx, c_ctx, ada_w, ada_b, norm_g, ffn_wg, ffn_wu, ffn_wd, w_in, w_out, out_g,
              lru_conv_w, lru_conv_b, lru_wa, lru_ba, lru_wx, lru_bx, lru_lam,
              hy_conv_w, hy_conv_b, hy_bias, filt_w1, filt_b1, filt_w2, filt_b2, filt_w3, filt_b3,
              filt_w4, filt_b4, filt_freq, final_g):
    n_lat = x.shape[1]
    n_ctx = ctx.shape[1]
    silu_lat = jax.nn.silu(c)[:, None, :]
    silu_ctx = jax.nn.silu(c_ctx)[None, None, :]
    xl = x
    xc = ctx
    for l in range(DEPTH):
        last = l == DEPTH - 1
        col_major = l % 2 == 1
        mod_l = jnp.split(silu_lat @ ada_w[l] + ada_b[l], N_MOD, axis=-1)
        mod_c = jnp.split(silu_ctx @ ada_w[l] + ada_b[l], N_MOD, axis=-1)
        filt = (filt_w1[l], filt_b1[l], filt_w2[l], filt_b2[l], filt_w3[l], filt_b3[l],
                filt_w4[l], filt_b4[l], filt_freq[l])

        xl = ffn_sublayer(xl, mod_l[0:3], norm_g[l, 0], ffn_wg[l, 0], ffn_wu[l, 0], ffn_wd[l, 0])
        xc = ffn_sublayer(xc, mod_c[0:3], norm_g[l, 0], ffn_wg[l, 0], ffn_wu[l, 0], ffn_wd[l, 0])

        ul = modulate(xl, norm_g[l, 1], mod_l[3], mod_l[4])
        uc = modulate(xc, norm_g[l, 1], mod_c[3], mod_c[4])
        if col_major:
            ul = to_col_major(ul)
        pl = ul @ w_in[l]
        pc = uc @ (w_in[l][:, :LRU_W] if last else w_in[l])

        cv_l = dw_conv(pl[..., :LRU_W], lru_conv_w[l], lru_conv_b[l])
        cv_c = dw_conv(pc[..., :LRU_W], lru_conv_w[l], lru_conv_b[l])
        h_lat, h_ctx = bidir_rglru(cv_c, cv_l, lru_wa[l], lru_ba[l], lru_wx[l], lru_bx[l], lru_lam[l], not last)

        k_lat = hyena_filters(n_lat, *filt)
        y_hy_l = hyena(pl[..., 2 * LRU_W:], hy_conv_w[l], hy_conv_b[l], k_lat, hy_bias[l])
        y_lat = merge_groups(h_lat, pl[..., LRU_W:2 * LRU_W], y_hy_l, out_g[l], w_out[l])
        if col_major:
            y_lat = from_col_major(y_lat)
        xl = xl + mod_l[5] * y_lat

        xl = ffn_sublayer(xl, mod_l[6:9], norm_g[l, 2], ffn_wg[l, 1], ffn_wu[l, 1], ffn_wd[l, 1])

        if not last:
            k_ctx = hyena_filters(n_ctx, *filt)
            y_hy_c = hyena(pc[..., 2 * LRU_W:], hy_conv_w[l], hy_conv_b[l], k_ctx, hy_bias[l])
            y_ctx = merge_groups(h_ctx, pc[..., LRU_W:2 * LRU_W], y_hy_c, out_g[l], w_out[l])
            xc = xc + mod_c[5] * y_ctx
            xc = ffn_sublayer(xc, mod_c[6:9], norm_g[l, 2], ffn_wg[l, 1], ffn_wu[l, 1], ffn_wd[l, 1])

    return rms_norm(xl, final_g)
```

```cpp
#include <hip/hip_runtime.h>
#include <cstdio>
#include <cstdint>

#ifndef MK_ONE_LAUNCH
#define MK_ONE_LAUNCH 1
#endif

#define GAS __attribute__((address_space(1)))
#define LAS __attribute__((address_space(3)))
typedef unsigned short bf16;
typedef unsigned v4u __attribute__((ext_vector_type(4)));
typedef unsigned v2u __attribute__((ext_vector_type(2)));
typedef float f32x4 __attribute__((ext_vector_type(4)));
typedef float f32x2 __attribute__((ext_vector_type(2)));
typedef short bf16x8 __attribute__((ext_vector_type(8)));
typedef _Float16 xh;
typedef _Float16 h4 __attribute__((ext_vector_type(4)));
typedef _Float16 h8 __attribute__((ext_vector_type(8)));

constexpr int D = 2048, SEQ = 8192, CTX = 256, MROWS = SEQ + CTX, DEPTH = 4, DFF = 5632;
constexpr int LRU_W = 1024, HY_W = 1024, IN_COLS = 5120, NMODC = 9 * D;
constexpr int GRID_W = 64, GRID_R = SEQ / GRID_W;
constexpr int FFTN = 16384, SPEC_PITCH = 8200;
constexpr float EPS = 1e-6f;
constexpr int NCHUNK = MROWS / 32;

constexpr size_t al256(size_t x) { return (x + 255) & ~(size_t)255; }
constexpr size_t WS_CTL = 0, CTL_BYTES = 1u << 20;
constexpr size_t WS_WUP = WS_CTL + CTL_BYTES;
constexpr size_t WS_WDN = WS_WUP + (size_t)DEPTH * 2 * 2 * DFF * D * 2;
constexpr size_t WS_WIN = WS_WDN + (size_t)DEPTH * 2 * D * DFF * 2;
constexpr size_t WS_WOUT = WS_WIN + (size_t)DEPTH * IN_COLS * D * 2;
constexpr size_t WS_WLRU = WS_WOUT + (size_t)DEPTH * D * D * 2;
constexpr size_t WS_MODS = WS_WLRU + (size_t)DEPTH * 4096 * 256 * 2;
constexpr size_t WS_SP8 = al256(WS_MODS + (size_t)DEPTH * 2 * NMODC * 4);
constexpr size_t WS_KTC = WS_SP8 + (size_t)DEPTH * 2 * 1024 * 4;
constexpr size_t WS_W4P = WS_KTC + (size_t)DEPTH * 2048 * 256 * 4;
constexpr size_t WS_SPEC = WS_W4P + (size_t)DEPTH * 64 * 4 * 2 * 64 * 16;
constexpr size_t WS_NORM = WS_CTL + 65536;
constexpr size_t WS_X = WS_SPEC + (size_t)DEPTH * 512 * SPEC_PITCH * 8;
constexpr size_t WS_U = WS_X + (size_t)MROWS * D * 4;
constexpr size_t WS_H = WS_U + (size_t)MROWS * D * 2;
constexpr size_t WS_CARRY = WS_H + (size_t)MROWS * DFF * 2;
constexpr size_t WS_SUMA = WS_CARRY + (size_t)2 * NCHUNK * 1024 * 4;
constexpr size_t WS_SUMB = WS_SUMA + (size_t)2 * NCHUNK * 1024 * 4;
constexpr size_t WS_WCTX = WS_SUMB + (size_t)2 * NCHUNK * 1024 * 4;
constexpr size_t WS_YCTX = WS_WCTX + (size_t)CTX * 1024 * 4;
constexpr size_t WS_SLAB = WS_YCTX + (size_t)CTX * 1024 * 4;
constexpr size_t WS_BIG = WS_SLAB + (size_t)11 * CTX * D * 4;
constexpr size_t WS_KT8 = WS_BIG;
constexpr size_t WS_P = WS_BIG;
constexpr size_t WS_CVF = WS_P + (size_t)MROWS * IN_COLS * 2;
constexpr size_t WS_CVB = WS_CVF + (size_t)MROWS * 1024 * 4;
constexpr size_t WS_X0 = WS_CVB + (size_t)MROWS * 1024 * 2;
constexpr size_t WS_WT = WS_X0 + (size_t)MROWS * 1024 * 4;
constexpr size_t WS_YT = WS_WT + (size_t)1024 * SEQ * 2;
constexpr size_t WS_ABP = WS_YT + (size_t)1024 * SEQ * 2;
constexpr size_t WS_END_ACT = WS_ABP + (size_t)2 * MROWS * 1024 * 4;
constexpr size_t WS_END_KT8 = WS_KT8 + (size_t)DEPTH * 2048 * 8192 * 4;
constexpr size_t WS_END = WS_END_ACT > WS_END_KT8 ? WS_END_ACT : WS_END_KT8;
static_assert(WS_END < (size_t)2300 * 1000 * 1000, "workspace map exceeds the guaranteed d_ws size");

constexpr int LDS_MAIN = 131072, LDS_BYTES = 147456;
constexpr int LDS_EXTRA = LDS_MAIN, LDS_CTLW = LDS_BYTES - 64;

namespace pg8 {
typedef unsigned short bf16_t;
typedef unsigned u32x4 __attribute__((ext_vector_type(4)));
constexpr int BM = 256, BK = 64, HALF = 128, HTB = HALF * BK * 2, STAGE_BYTES = 8 * HTB, NXCD = 8, WGM = 8;
__host__ __device__ __forceinline__ int lds_byte(int r, int c) { const int st = (r >> 4) * 2 + (c >> 5), rr = r & 15, cc = c & 31, ob = rr * 64 + cc * 2; return st * 1024 + (ob ^ (((ob >> 9) & 1) << 5)); }
__host__ __device__ __forceinline__ void stage_rc(int b, int& R, int& C) { const int st = b / 1024, sb = b % 1024, swz = sb ^ (((sb >> 9) & 1) << 5); R = (st >> 1) * 16 + swz / 64; C = (st & 1) * 32 + (swz % 64) / 2; }
__host__ __device__ __forceinline__ int perm32(int rho) { const int n = rho >> 4, i = rho & 15; return 8 * (i >> 2) + 4 * n + (i & 3); }
struct Unit { int pm, pn; };
struct Gemm { const bf16_t* A; const bf16_t* Bt; int M, N, K, lda, ldb, agrp_n, agrp_off, bmod, bgrp_off; };
struct StaticOrder {
    int nM, nN, nwg, G, c, rev;
    __host__ __device__ void init(int M, int N, int G_, int c_, int rev_ = 0) { nM = M / BM; nN = N / BM; nwg = nM * nN; G = G_; c = c_; rev = rev_; }
    __host__ __device__ bool next(int i, Unit& u) const {
        const long L = (long)i * G + c; if (L >= nwg) return false;
        int wgid = (int)L; { const int q = nwg / NXCD, r = nwg % NXCD, xcd = wgid % NXCD; int off = wgid / NXCD; if (rev) off = (xcd < r ? q + 1 : q) - 1 - off;
            wgid = (xcd < r ? xcd * (q + 1) : r * (q + 1) + (xcd - r) * q) + off; }
        const int nig = WGM * nN, gid = wgid / nig, fm = gid * WGM, gsz = (nM - fm) < WGM ? (nM - fm) : WGM;
        u.pm = fm + ((wgid % nig) % gsz); u.pn = (wgid % nig) / gsz; return true;
    }
};
__device__ __forceinline__ unsigned cvt_pk_bf16(float lo, float hi) { unsigned r; asm volatile("v_cvt_pk_bf16_f32 %0, %1, %2" : "=v"(r) : "v"(lo), "v"(hi)); return r; }

#ifndef PG8_SP2
#define PG8_SP2 true
#endif
template <class Epi, bool ALIGN_EPI = true, bool SP2 = PG8_SP2>
__device__ __forceinline__ void gemm_phase(LAS unsigned char* lds, const Gemm g, const StaticOrder& S, const Epi& E) {
    int tid = threadIdx.x; asm volatile("" : "+v"(tid));
    const int wid = __builtin_amdgcn_readfirstlane(tid >> 6), lane = tid & 63, wr = wid >> 2, wc = wid & 3, fr = lane & 15, fq = lane >> 4;
    const int K = g.K, nt = K / BK;
    unsigned voffA[2], voffB[2];
#pragma unroll
    for (int i = 0; i < 2; ++i) { int R, C; stage_rc(tid * 16 + i * 8192, R, C); const int Rb = Epi::PERM ? ((R & ~31) + perm32(R & 31)) : R;
        voffA[i] = (unsigned)(R * g.lda + C) * 2u; voffB[i] = (unsigned)(Rb * g.ldb + C) * 2u; }
    const size_t kstep = (size_t)(BK * 2);
    const size_t hstepA = (size_t)HALF * g.lda * 2, hstepB = (size_t)HALF * g.ldb * 2;
    const size_t tstepA = 2 * hstepA, tstepB = 2 * hstepB;
    const unsigned ldsw = (unsigned)wid * 1024u;
    const int aoff = lds_byte(wr * 64 + fr, fq * 8), boff = lds_byte(wc * 32 + fr, fq * 8);
#define PG8_SA(b, h) (((b) * 2 + (h)) * HTB)
#define PG8_SB(b, h) ((4 + (b) * 2 + (h)) * HTB)
#define PG8_STAGE(bufoff, gbase, voff) do { _Pragma("unroll") for (int _i = 0; _i < 2; ++_i) \
        __builtin_amdgcn_global_load_lds((const GAS unsigned*)((const char*)(gbase) + (voff)[_i]), (LAS unsigned*)(lds + (bufoff) + ldsw + _i * 8192), 16, 0, 0); } while (0)
#define PG8_LDA(dst, b, h) do { _Pragma("unroll") for (int m = 0; m < 4; ++m) _Pragma("unroll") for (int k = 0; k < 2; ++k) dst[m][k] = *(const LAS bf16x8*)(lds + PG8_SA(b, h) + aoff + m * 2048 + k * 1024); } while (0)
#define PG8_LDB(dst, b, h) do { _Pragma("unroll") for (int n = 0; n < 2; ++n) _Pragma("unroll") for (int k = 0; k < 2; ++k) dst[n][k] = *(const LAS bf16x8*)(lds + PG8_SB(b, h) + boff + n * 2048 + k * 1024); } while (0)
#define PG8_MMA(ai, bj, At, Bt) do { __builtin_amdgcn_s_setprio(1); _Pragma("unroll") for (int m = 0; m < 4; ++m) _Pragma("unroll") for (int n = 0; n < 2; ++n) _Pragma("unroll") for (int k = 0; k < 2; ++k) \
        acc[ai][bj][m][n] = __builtin_amdgcn_mfma_f32_16x16x32_bf16(Bt[n][k], At[m][k], acc[ai][bj][m][n], 0, 0, 0); __builtin_amdgcn_s_setprio(0); } while (0)
#define PG8_WAIT_V(n) asm volatile("s_waitcnt vmcnt(" #n ")" ::: "memory")
#define PG8_WAIT_L(n) asm volatile("s_waitcnt lgkmcnt(" #n ")" ::: "memory")
#define PG8_BAR __builtin_amdgcn_s_barrier()
#define PG8_SCHED __builtin_amdgcn_sched_barrier(0)
    Unit cur, nxt; int ui = 0;
    if (!S.next(0, cur)) return;
    f32x4 acc[2][2][4][2];
#pragma unroll
    for (int a = 0; a < 2; ++a)
#pragma unroll
        for (int b = 0; b < 2; ++b)
#pragma unroll
            for (int m = 0; m < 4; ++m)
#pragma unroll
                for (int n = 0; n < 2; ++n) acc[a][b][m][n] = (f32x4){0.f, 0.f, 0.f, 0.f};
    bf16x8 At[4][2], B0[2][2], B1[2][2];
    const char* cA = (const char*)g.A + (size_t)cur.pm * tstepA + (size_t)((cur.pn / g.agrp_n) * g.agrp_off) * 2; const char* cB = (const char*)g.Bt + (size_t)(cur.pn % g.bmod) * tstepB + (size_t)((cur.pn / g.bmod) * g.bgrp_off) * 2;
    if constexpr (SP2) {
    PG8_STAGE(PG8_SB(0, 0), cB, voffB); PG8_STAGE(PG8_SB(0, 1), cB + hstepB, voffB); PG8_STAGE(PG8_SA(0, 0), cA, voffA); PG8_STAGE(PG8_SA(0, 1), cA + hstepA, voffA);
    if (wr == 1) PG8_BAR;
    PG8_WAIT_V(2); PG8_BAR;
    PG8_STAGE(PG8_SB(1, 0), cB + kstep, voffB); PG8_STAGE(PG8_SA(1, 0), cA + kstep, voffA); PG8_STAGE(PG8_SB(1, 1), cB + hstepB + kstep, voffB);
    PG8_WAIT_V(6); PG8_BAR;
    } else {
    PG8_STAGE(PG8_SB(0, 0), cB, voffB); PG8_STAGE(PG8_SA(0, 0), cA, voffA); PG8_STAGE(PG8_SB(0, 1), cB + hstepB, voffB); PG8_STAGE(PG8_SA(0, 1), cA + hstepA, voffA);
    if (wr == 1) PG8_BAR;
    PG8_WAIT_V(4); PG8_BAR;
    PG8_STAGE(PG8_SB(1, 0), cB + kstep, voffB); PG8_STAGE(PG8_SA(1, 0), cA + kstep, voffA); PG8_STAGE(PG8_SB(1, 1), cB + hstepB + kstep, voffB);
    PG8_WAIT_V(6); PG8_BAR;
    }
    for (;;) {
        const bool has_next = S.next(ui + 1, nxt);
        const char* nA = has_next ? (const char*)g.A + (size_t)nxt.pm * tstepA + (size_t)((nxt.pn / g.agrp_n) * g.agrp_off) * 2 : cA;
        const char* nB = has_next ? (const char*)g.Bt + (size_t)(nxt.pn % g.bmod) * tstepB + (size_t)((nxt.pn / g.bmod) * g.bgrp_off) * 2 : cB;
#pragma unroll 1
        for (int t = 0; t < nt; t += 2) {
            const bool last = (t == nt - 2);
            const char* a1 = cA + (size_t)(t + 1) * kstep;
            const char* a2 = last ? nA : cA + (size_t)(t + 2) * kstep; const char* b2 = last ? nB : cB + (size_t)(t + 2) * kstep;
            const char* a3 = a2 + kstep; const char* b3 = b2 + kstep;
            if constexpr (SP2) {
            PG8_LDB(B0, 0, 0); PG8_LDB(B1, 0, 1); PG8_SCHED; PG8_LDA(At, 0, 0); PG8_STAGE(PG8_SA(1, 1), a1 + hstepA, voffA);
            PG8_WAIT_V(8); PG8_WAIT_L(0); PG8_BAR; PG8_MMA(0, 0, At, B0); PG8_MMA(0, 1, At, B1); PG8_BAR; PG8_SCHED;
            PG8_LDA(At, 0, 1); PG8_STAGE(PG8_SB(0, 0), b2, voffB); PG8_STAGE(PG8_SB(0, 1), b2 + hstepB, voffB); PG8_STAGE(PG8_SA(0, 0), a2, voffA);
            PG8_WAIT_V(8); PG8_WAIT_L(0); PG8_BAR; PG8_MMA(1, 0, At, B0); PG8_MMA(1, 1, At, B1); PG8_BAR; PG8_SCHED;
            PG8_LDB(B0, 1, 0); PG8_LDB(B1, 1, 1); PG8_SCHED; PG8_LDA(At, 1, 0); PG8_STAGE(PG8_SA(0, 1), a2 + hstepA, voffA);
            PG8_WAIT_V(8); PG8_WAIT_L(0); PG8_BAR; PG8_MMA(0, 0, At, B0); PG8_MMA(0, 1, At, B1); PG8_BAR; PG8_SCHED;
            PG8_LDA(At, 1, 1); PG8_STAGE(PG8_SB(1, 0), b3, voffB); PG8_STAGE(PG8_SB(1, 1), b3 + hstepB, voffB); PG8_STAGE(PG8_SA(1, 0), a3, voffA);
            PG8_WAIT_V(8); PG8_WAIT_L(0); PG8_BAR; PG8_MMA(1, 0, At, B0); PG8_MMA(1, 1, At, B1); PG8_BAR; PG8_SCHED;
            } else {
            PG8_LDB(B0, 0, 0); PG8_SCHED; PG8_LDA(At, 0, 0); PG8_STAGE(PG8_SA(1, 1), a1 + hstepA, voffA);
            PG8_WAIT_L(8); PG8_BAR; PG8_WAIT_L(0); PG8_MMA(0, 0, At, B0); PG8_BAR; PG8_SCHED;
            PG8_LDB(B1, 0, 1); PG8_STAGE(PG8_SB(0, 0), b2, voffB);
            PG8_BAR; PG8_WAIT_L(0); PG8_MMA(0, 1, At, B1); PG8_BAR;
            PG8_LDA(At, 0, 1); PG8_STAGE(PG8_SA(0, 0), a2, voffA);
            PG8_BAR; PG8_WAIT_L(0); PG8_MMA(1, 0, At, B0); PG8_BAR; PG8_SCHED;
            PG8_STAGE(PG8_SB(0, 1), b2 + hstepB, voffB);
            PG8_WAIT_V(6); PG8_BAR; PG8_MMA(1, 1, At, B1); PG8_BAR;
            PG8_LDB(B0, 1, 0); PG8_SCHED; PG8_LDA(At, 1, 0); PG8_STAGE(PG8_SA(0, 1), a2 + hstepA, voffA);
            PG8_WAIT_L(8); PG8_BAR; PG8_WAIT_L(0); PG8_MMA(0, 0, At, B0); PG8_BAR; PG8_SCHED;
            PG8_LDB(B1, 1, 1); PG8_STAGE(PG8_SB(1, 0), b3, voffB);
            PG8_BAR; PG8_WAIT_L(0); PG8_MMA(0, 1, At, B1); PG8_BAR;
            PG8_LDA(At, 1, 1); PG8_STAGE(PG8_SA(1, 0), a3, voffA);
            PG8_BAR; PG8_WAIT_L(0); PG8_MMA(1, 0, At, B0); PG8_BAR; PG8_SCHED;
            PG8_STAGE(PG8_SB(1, 1), b3 + hstepB, voffB);
            PG8_WAIT_V(6); PG8_BAR; PG8_MMA(1, 1, At, B1); PG8_BAR;
            }
        }
        if constexpr (ALIGN_EPI) { if (wr == 0) PG8_BAR; }
        E(acc, cur, wr, wc, fr, fq);
#ifdef DBG_EPI2
        if (Epi::PERM) { asm volatile("s_waitcnt vmcnt(0)" ::: "memory"); E(acc, cur, wr, wc, fr, fq); }
#endif
        if (!has_next) break;
#pragma unroll
        for (int a = 0; a < 2; ++a)
#pragma unroll
            for (int b = 0; b < 2; ++b)
#pragma unroll
                for (int m = 0; m < 4; ++m)
#pragma unroll
                    for (int n = 0; n < 2; ++n) acc[a][b][m][n] = (f32x4){0.f, 0.f, 0.f, 0.f};
        cur = nxt; cA = nA; cB = nB; ++ui;
        if constexpr (ALIGN_EPI) { if (wr == 1) PG8_BAR; }
    }
    PG8_WAIT_V(0);
    if constexpr (!ALIGN_EPI) { if (wr == 0) PG8_BAR; }
    PG8_BAR;
#undef PG8_SA
#undef PG8_SB
#undef PG8_STAGE
#undef PG8_LDA
#undef PG8_LDB
#undef PG8_MMA
#undef PG8_WAIT_V
#undef PG8_WAIT_L
#undef PG8_BAR
#undef PG8_SCHED
}
}

__device__ __forceinline__ unsigned f2bf(float f) { unsigned u = __builtin_bit_cast(unsigned, f); return (u + 0x7fffu + ((u >> 16) & 1u)) >> 16; }
__device__ __forceinline__ unsigned pk2(float lo, float hi) { return f2bf(lo) | (f2bf(hi) << 16); }
__device__ __forceinline__ float sigmoid_f(float x) { return 1.0f / (1.0f + __expf(-x)); }
__device__ __forceinline__ float silu_f(float x) { return x / (1.0f + __expf(-x)); }
__device__ __forceinline__ float gelu_tanh_f(float x) { const float u = 0.7978845608028654f * (x + 0.044715f * x * x * x); const float th = 1.0f - 2.0f * __builtin_amdgcn_rcpf(1.0f + __expf(2.0f * u)); return 0.5f * x * (1.0f + th); }
__device__ __forceinline__ float wave_sum(float v) {
#pragma unroll
    for (int o = 1; o < 64; o <<= 1) v += __shfl_xor(v, o);
    return v;
}
#define LDS_WAIT() asm volatile("s_waitcnt lgkmcnt(0)" ::: "memory")
__device__ __forceinline__ unsigned pack_h2(float lo, float hi) { const _Float16 a = (_Float16)lo, b = (_Float16)hi; return (unsigned)__builtin_bit_cast(unsigned short, a) | ((unsigned)__builtin_bit_cast(unsigned short, b) << 16); }
__device__ __forceinline__ float h_lo(unsigned w) { return (float)__builtin_bit_cast(_Float16, (unsigned short)(w & 0xffffu)); }
__device__ __forceinline__ float lru_step(float la, float bp, float h) { const float a = __expf(la); return a * h + __builtin_amdgcn_sqrtf(fmaxf(1.0f - a * a, 0.f)) * bp; }
__device__ __forceinline__ float h_hi(unsigned w) { return (float)__builtin_bit_cast(_Float16, (unsigned short)(w >> 16)); }
__device__ __forceinline__ float bf_lo(unsigned w) { return __builtin_bit_cast(float, w << 16); }
__device__ __forceinline__ float bf_hi2(unsigned w) { return __builtin_bit_cast(float, w & 0xffff0000u); }

__device__ __forceinline__ void st16_wt(void* p, v4u v) { asm volatile("global_store_dwordx4 %0, %1, off sc1\n\ts_nop 1" ::"v"(p), "v"(v) : "memory"); }
struct EpiSwiGLU {
    static constexpr bool PERM = true;
    bf16* H; unsigned* cnt;
    __device__ __forceinline__ void operator()(const f32x4 (&acc)[2][2][4][2], const pg8::Unit& u, int wr, int wc, int fr, int fq) const {
        const int row0 = u.pm * 256 + wr * 64 + fr, col0 = u.pn * 128 + wc * 32 + 8 * fq;
#pragma unroll
        for (int ai = 0; ai < 2; ++ai)
#pragma unroll
            for (int m = 0; m < 4; ++m) {
                bf16* rowp = H + (size_t)(row0 + ai * 128 + m * 16) * DFF + col0;
                float o[8];
#pragma unroll
                for (int n = 0; n < 2; ++n)
#pragma unroll
                    for (int j = 0; j < 4; ++j) { const float gv = acc[ai][0][m][n][j], uv = acc[ai][1][m][n][j]; o[n * 4 + j] = gv * __builtin_amdgcn_rcpf(1.0f + __expf(-gv)) * uv; }
                v4u w; w.x = pg8::cvt_pk_bf16(o[0], o[1]); w.y = pg8::cvt_pk_bf16(o[2], o[3]); w.z = pg8::cvt_pk_bf16(o[4], o[5]); w.w = pg8::cvt_pk_bf16(o[6], o[7]);
                st16_wt(rowp, w);
            }
        if (u.pm == MROWS / 256 - 1) {
            asm volatile("s_waitcnt vmcnt(0)" ::: "memory");
            if ((fr | fq) == 0) (void)__hip_atomic_fetch_add(cnt, 1u, __ATOMIC_RELAXED, __HIP_MEMORY_SCOPE_AGENT);
        }
    }
};
struct EpiResid {
    static constexpr bool PERM = true;
    xh* X; const float* gate_l; float sc; int permute;
    __device__ __forceinline__ void operator()(const f32x4 (&acc)[2][2][4][2], const pg8::Unit& u, int wr, int wc, int fr, int fq) const {
        const int row0 = u.pm * 256 + wr * 64 + fr, col0 = u.pn * 256 + wc * 32 + 8 * fq;
        f32x4 gv[2][2];
#pragma unroll
        for (int bj = 0; bj < 2; ++bj)
#pragma unroll
            for (int n = 0; n < 2; ++n) gv[bj][n] = *(const f32x4*)(gate_l + col0 + bj * 128 + n * 4) * sc;
#pragma unroll
        for (int ai = 0; ai < 2; ++ai) {
            xh* rowp[4]; h8 xv[4][2];
#pragma unroll
            for (int m = 0; m < 4; ++m) { int row = row0 + ai * 128 + m * 16; if (permute && row < SEQ) row = (row & (GRID_R - 1)) * GRID_W + (row >> 7); rowp[m] = X + (size_t)row * D + col0; }
#pragma unroll
            for (int m = 0; m < 4; ++m)
#pragma unroll
                for (int bj = 0; bj < 2; ++bj) xv[m][bj] = *(const h8*)(rowp[m] + bj * 128);
#pragma unroll
            for (int m = 0; m < 4; ++m)
#pragma unroll
                for (int bj = 0; bj < 2; ++bj) {
                    const f32x4 lo = __builtin_convertvector(__builtin_shufflevector(xv[m][bj], xv[m][bj], 0, 1, 2, 3), f32x4) + gv[bj][0] * acc[ai][bj][m][0];
                    const f32x4 hi = __builtin_convertvector(__builtin_shufflevector(xv[m][bj], xv[m][bj], 4, 5, 6, 7), f32x4) + gv[bj][1] * acc[ai][bj][m][1];
                    const h4 l4 = __builtin_convertvector(lo, h4), h4v = __builtin_convertvector(hi, h4);
                    const h8 o8 = __builtin_shufflevector(l4, h4v, 0, 1, 2, 3, 4, 5, 6, 7);
                    st16_wt(rowp[m] + bj * 128, __builtin_bit_cast(v4u, o8));
                }
        }
    }
};
struct EpiSlab {
    static constexpr bool PERM = false;
    xh* S; const float* gate; float sc; int ntile;
    __device__ __forceinline__ void operator()(const f32x4 (&acc)[2][2][4][2], const pg8::Unit& u, int wr, int wc, int fr, int fq) const {
        const int row0 = u.pm * 256 + wr * 64 + fr, col0 = (u.pn % ntile) * 256 + wc * 32 + 4 * fq;
        xh* base = S + (size_t)(u.pn / ntile) * CTX * D;
#pragma unroll
        for (int bj = 0; bj < 2; ++bj)
#pragma unroll
            for (int n = 0; n < 2; ++n) { const f32x4 gv = *(const f32x4*)(gate + col0 + bj * 128 + n * 16) * sc;
#pragma unroll
                for (int ai = 0; ai < 2; ++ai)
#pragma unroll
                    for (int m = 0; m < 4; ++m) *(h4*)(base + (size_t)(row0 + ai * 128 + m * 16) * D + col0 + bj * 128 + n * 16) = __builtin_convertvector(gv * acc[ai][bj][m][n], h4); }
    }
};
struct EpiBf16Out {
    static constexpr bool PERM = true;
    bf16* O; int ldc;
    __device__ __forceinline__ void operator()(const f32x4 (&acc)[2][2][4][2], const pg8::Unit& u, int wr, int wc, int fr, int fq) const {
        const int row0 = u.pm * 256 + wr * 64 + fr, col0 = u.pn * 256 + wc * 32 + 8 * fq;
#pragma unroll
        for (int ai = 0; ai < 2; ++ai)
#pragma unroll
            for (int m = 0; m < 4; ++m) { bf16* rowp = O + (size_t)(row0 + ai * 128 + m * 16) * ldc + col0;
#pragma unroll
                for (int bj = 0; bj < 2; ++bj) { const f32x4 v0 = acc[ai][bj][m][0], v1 = acc[ai][bj][m][1];
                    v4u w; w.x = pg8::cvt_pk_bf16(v0[0], v0[1]); w.y = pg8::cvt_pk_bf16(v0[2], v0[3]); w.z = pg8::cvt_pk_bf16(v1[0], v1[1]); w.w = pg8::cvt_pk_bf16(v1[2], v1[3]);
                    st16_wt(rowp + bj * 128, w); } }
    }
};
struct EpiF32 {
    static constexpr bool PERM = false;
    float* C; int ldc;
    __device__ __forceinline__ void operator()(const f32x4 (&acc)[2][2][4][2], const pg8::Unit& u, int wr, int wc, int fr, int fq) const {
        const int row0 = u.pm * 256 + wr * 64 + fr, col0 = u.pn * 256 + wc * 32 + 4 * fq;
#pragma unroll
        for (int ai = 0; ai < 2; ++ai)
#pragma unroll
            for (int m = 0; m < 4; ++m) { float* rowp = C + (size_t)(row0 + ai * 128 + m * 16) * ldc + col0;
#pragma unroll
                for (int bj = 0; bj < 2; ++bj)
#pragma unroll
                    for (int n = 0; n < 2; ++n) *(f32x4*)(rowp + bj * 128 + n * 16) = acc[ai][bj][m][n]; }
    }
};
struct EpiGates {
    static constexpr bool PERM = false;
    const float* ba; const float* bx; const float* sp8;
    const bf16* cvb; unsigned* ABP;
    __device__ __forceinline__ void operator()(const f32x4 (&acc)[2][2][4][2], const pg8::Unit& u, int wr, int wc, int fr, int fq) const {
        const int head = u.pn >> 2, d = (u.pn >> 1) & 1, c2 = u.pn & 1;
        const int row0 = u.pm * 256 + wr * 64 + fr, ch0 = head * 256 + c2 * 128 + wc * 32 + 4 * fq;
        v2u cvw[2][2][4];
#pragma unroll
        for (int n = 0; n < 2; ++n)
#pragma unroll
            for (int ai = 0; ai < 2; ++ai)
#pragma unroll
                for (int m = 0; m < 4; ++m) cvw[n][ai][m] = *(const v2u*)(cvb + (size_t)(row0 + ai * 128 + m * 16) * 1024 + ch0 + n * 16);
#pragma unroll
        for (int n = 0; n < 2; ++n) {
            const f32x4 vba = *(const f32x4*)(ba + d * 1024 + ch0 + n * 16), vbx = *(const f32x4*)(bx + d * 1024 + ch0 + n * 16), vsp = *(const f32x4*)(sp8 + d * 1024 + ch0 + n * 16);
#pragma unroll
            for (int ai = 0; ai < 2; ++ai)
#pragma unroll
                for (int m = 0; m < 4; ++m) {
                    const size_t off = (size_t)(row0 + ai * 128 + m * 16) * 1024 + ch0 + n * 16;
                    const v2u cw = cvw[n][ai][m]; const f32x4 cv = {bf_lo(cw.x), bf_hi2(cw.x), bf_lo(cw.y), bf_hi2(cw.y)};
                    v4u pk;
#pragma unroll
                    for (int j = 0; j < 4; ++j) {
                        const float za = fminf(fmaxf(acc[ai][0][m][n][j] + vba[j], -60.f), 60.f), zx = fminf(fmaxf(acc[ai][1][m][n][j] + vbx[j], -60.f), 60.f);
                        const float pa = 1.0f + __expf(-za), px = 1.0f + __expf(-zx), rp = __builtin_amdgcn_rcpf(pa * px);
                        const float r = px * rp, ig = pa * rp;
                        const float la = -r * vsp[j];
                        pk[j] = pack_h2(la, ig * cv[j]);
                    }
                    st16_wt(ABP + (size_t)d * MROWS * 1024 + off, pk);
                }
        }
    }
};

#define XB_TMO      128
#define XB_XCNT(j)  (256  + 64 * (j))
#define XB_XSUB(j)  (1280 + 64 * (j))
#define XB_XGEN(j)  (2304 + 64 * (j))
#define XB_TOP      3328
#define XB_TOPGEN   3392
#define XCD_BAR_WORDS 3456
#define XB_SPIN_CAP (1u << 18)
__device__ __forceinline__ unsigned xb_ld(unsigned* p)              { return __hip_atomic_load(p, __ATOMIC_RELAXED, __HIP_MEMORY_SCOPE_AGENT); }
__device__ __forceinline__ unsigned xb_add(unsigned* p, unsigned v) { return __hip_atomic_fetch_add(p, v, __ATOMIC_RELAXED, __HIP_MEMORY_SCOPE_AGENT); }
__device__ __forceinline__ unsigned xb_xcc_id() { return (unsigned)__builtin_amdgcn_s_getreg((3 << 11) | 20) & 0xFu; }
#define XB_SPIN(cond, bar) do { unsigned _sp = 0; while (cond) { __builtin_amdgcn_s_sleep(1); \
    if ((++_sp & 255u) == 0u) { if (xb_ld(&(bar)[XB_TMO])) break; if (_sp > XB_SPIN_CAP) { atomicAdd(&(bar)[XB_TMO], 1u); break; } } } } while (0)
struct XcdBarrier { unsigned* bar; unsigned x; volatile LAS unsigned* st; };
__device__ __forceinline__ XcdBarrier xcd_barrier_post(unsigned* bar, volatile LAS unsigned* st) {
    XcdBarrier b; b.bar = bar; b.x = xb_xcc_id(); b.st = st;
    if (threadIdx.x == 0) (void)xb_add(&bar[XB_XCNT(b.x)], 1u);
    return b;
}
__device__ __forceinline__ void xcd_barrier_complete(unsigned* bar, unsigned x, unsigned& nloc, unsigned& nx) {
    const unsigned G = gridDim.x * gridDim.y * gridDim.z;
    unsigned sum, cnt, mine, sp = 0u;
    for (;;) {
        sum = 0u; cnt = 0u; mine = 0u;
#pragma unroll
        for (unsigned j = 0; j < 16; ++j) { const unsigned c = xb_ld(&bar[XB_XCNT(j)]); sum += c; cnt += (c > 0u) ? 1u : 0u; mine = (j == x) ? c : mine; }
        if (sum == G) break;
        __builtin_amdgcn_s_sleep(1);
        if ((++sp & 255u) == 0u) { if (xb_ld(&bar[XB_TMO])) break; if (sp > XB_SPIN_CAP) { atomicAdd(&bar[XB_TMO], 1u); break; } }
    }
    nloc = mine > 0u ? mine : 1u; nx = cnt > 0u ? cnt : 1u;
}
__device__ __forceinline__ void xcd_barrier(const XcdBarrier& b) {
    asm volatile("s_waitcnt vmcnt(0)" ::: "memory");
    __syncthreads();
    if (threadIdx.x == 0) {
        unsigned* bar = b.bar;
        __builtin_amdgcn_s_waitcnt(0);
        unsigned nloc = b.st[0], nx = b.st[1];
        if (nloc == 0u) { xcd_barrier_complete(bar, b.x, nloc, nx); b.st[0] = nloc; b.st[1] = nx; }
        const unsigned old = xb_add(&bar[XB_XSUB(b.x)], 1u);
        const unsigned gen = old / nloc;
        if (old + 1u == (gen + 1u) * nloc) {
            __builtin_amdgcn_fence(__ATOMIC_RELEASE, "agent");
            asm volatile("s_waitcnt vmcnt(0)" ::: "memory");
            const unsigned og = xb_add(&bar[XB_TOP], 1u);
            const unsigned tg = og / nx;
            if (og + 1u == (tg + 1u) * nx) xb_add(&bar[XB_TOPGEN], 1u);
            else XB_SPIN(xb_ld(&bar[XB_TOPGEN]) == tg, bar);
            __builtin_amdgcn_fence(__ATOMIC_ACQUIRE, "agent");
            xb_add(&bar[XB_XGEN(b.x)], 1u);
            asm volatile("s_waitcnt vmcnt(0)" ::: "memory");
        } else {
            XB_SPIN(xb_ld(&bar[XB_XGEN(b.x)]) == gen, bar);
            __builtin_amdgcn_fence(__ATOMIC_ACQUIRE, "agent");
            asm volatile("s_waitcnt vmcnt(0)" ::: "memory");
        }
    }
    __syncthreads();
}

enum InIdx { I_X = 0, I_C, I_CTX, I_CCTX, I_ADAW, I_ADAB, I_NORMG, I_WG, I_WU, I_WD, I_WIN, I_WOUT, I_OUTG, I_LCW, I_LCB, I_WA, I_BA, I_WX, I_BX, I_LAM,
             I_HCW, I_HCB, I_HBIAS, I_FW1, I_FB1, I_FW2, I_FB2, I_FW3, I_FB3, I_FW4, I_FB4, I_FREQ, I_FINALG, N_IN };
struct Args { const float* in[N_IN]; float* out; unsigned char* ws; int ph_lo, ph_hi; };
static_assert(sizeof(Args) == (N_IN + 2) * 8 + 8, "Args has no padding");

constexpr int PH_PRO0 = 0, PH_PRO1 = 1, PH_PRO2 = 2, PH_LAYER0 = 3, PH_PER_LAYER = 14, PH_FINAL = PH_LAYER0 + DEPTH * PH_PER_LAYER, N_PHASES = PH_FINAL + 1;

__device__ __forceinline__ void transpose_item(const float* W, int N, bf16* WT, int ldk, int dest_row0, int k0, int n0, LAS float* scr, int lane) {
    float wv_[32];
#pragma unroll
    for (int i = 0; i < 32; ++i) wv_[i] = W[(size_t)(k0 + 2 * i + (lane >> 5)) * N + n0 + (lane & 31)];
#pragma unroll
    for (int i = 0; i < 32; ++i) scr[(2 * i + (lane >> 5)) * 33 + (lane & 31)] = wv_[i];
    LDS_WAIT(); asm volatile("" ::: "memory");
    const int c = lane & 7;
#pragma unroll
    for (int j = 0; j < 4; ++j) { const int n = (lane >> 3) + 8 * j; const LAS float* s = scr + (8 * c) * 33 + n;
        v4u o; o.x = pk2(s[0 * 33], s[1 * 33]); o.y = pk2(s[2 * 33], s[3 * 33]); o.z = pk2(s[4 * 33], s[5 * 33]); o.w = pk2(s[6 * 33], s[7 * 33]);
        *(v4u*)(WT + (size_t)(dest_row0 + n) * ldk + k0 + 8 * c) = o; }
    LDS_WAIT(); asm volatile("" ::: "memory");
}

constexpr int CONV_UP = 4 * 32 * 176, CONV_DN = 2 * 88 * 64, CONV_IN = 32 * 160, CONV_OUT = 32 * 64, CONV_LRU = 16 * 32, CONV_PER_LAYER = CONV_UP + CONV_DN + CONV_IN + CONV_OUT + CONV_LRU;
constexpr int CONV_T_UP = 80 * 8 * 4, CONV_T_WIN = 108 * 8 * 10, CONV_T_SC = 208 * 8 * 3, CONV_T_DN = 0, CONV_T_WO = 192 * 8 * 3;
constexpr int CONV_T0 = 0, CONV_T1 = CONV_T0 + CONV_T_UP, CONV_T2 = CONV_T1 + CONV_T_WIN, CONV_T3 = CONV_T2 + CONV_T_SC, CONV_T4 = CONV_T3 + CONV_T_UP;
constexpr int CONV_T5 = CONV_T4 + CONV_T_DN, CONV_T6 = CONV_T5 + CONV_T_WO, CONV_TAIL_END = CONV_T6 + CONV_T_DN;
static_assert(CONV_PER_LAYER == 41472 && CONV_TAIL_END <= CONV_PER_LAYER, "conversion item map");
__device__ __forceinline__ void conv_item(const Args& a, int l, int r, LAS float* scr, int lane) {
    if (r < CONV_UP) { const int mat = r / 5632, q = r % 5632, kb = q / 176, nb = q % 176, lf = l * 2 + (mat >> 1), g = mat & 1, n0 = 32 * nb;
        transpose_item((g ? a.in[I_WU] : a.in[I_WG]) + (size_t)lf * D * DFF, DFF, (bf16*)(a.ws + WS_WUP) + (size_t)lf * 2 * DFF * D, D, 256 * (n0 >> 7) + 128 * g + (n0 & 127), 64 * kb, n0, scr, lane); return; }
    r -= CONV_UP;
    if (r < CONV_DN) { const int mat = l * 2 + r / 5632, q = r % 5632, kb = q / 64, nb = q % 64;
        transpose_item(a.in[I_WD] + (size_t)mat * DFF * D, D, (bf16*)(a.ws + WS_WDN) + (size_t)mat * D * DFF, DFF, 32 * nb, 64 * kb, 32 * nb, scr, lane); return; }
    r -= CONV_DN;
    if (r < CONV_IN) { const int kb = r / 160, nb = r % 160;
        transpose_item(a.in[I_WIN] + (size_t)l * D * IN_COLS, IN_COLS, (bf16*)(a.ws + WS_WIN) + (size_t)l * IN_COLS * D, D, 32 * nb, 64 * kb, 32 * nb, scr, lane); return; }
    r -= CONV_IN;
    if (r < CONV_OUT) { const int kb = r / 64, nb = r % 64;
        transpose_item(a.in[I_WOUT] + (size_t)l * D * D, D, (bf16*)(a.ws + WS_WOUT) + (size_t)l * D * D, D, 32 * nb, 64 * kb, 32 * nb, scr, lane); return; }
    r -= CONV_OUT;
    { const int mat = r / 32, q = r % 32, kb = q / 8, nb = q % 8, n0 = 32 * nb;
      const int h = mat & 3, d = (mat >> 2) & 1, g = (mat >> 3) & 1;
      const float* src = (g ? a.in[I_WX] : a.in[I_WA]) + (size_t)((l * 2 + d) * 4 + h) * 65536;
      transpose_item(src, 256, (bf16*)(a.ws + WS_WLRU) + (size_t)l * 4096 * 256, 256, h * 1024 + (d * 2 + (n0 >> 7)) * 256 + g * 128 + (n0 & 127), 64 * kb, n0, scr, lane); }
}
__device__ __forceinline__ void conv_range(const Args& a, LAS unsigned char* lds, int l, int lo, int hi, int widx, int nw, int wave, int lane) {
    LAS float* scr = (LAS float*)(lds + wave * 8448);
    for (int r = lo + widx; r < hi; r += nw) conv_item(a, l, r, scr, lane);
}
__device__ __forceinline__ void pro_weights(const Args& a, LAS unsigned char* lds, int gw, int ngw, int wave, int lane) {
    LAS float* scr = (LAS float*)(lds + wave * 8448);
    constexpr int REST = CONV_PER_LAYER - CONV_TAIL_END, NITEMS = CONV_PER_LAYER + (DEPTH - 1) * REST;
    for (int it = gw; it < NITEMS; it += ngw) {
        if (it < CONV_PER_LAYER) conv_item(a, 0, it, scr, lane);
        else { const int q = it - CONV_PER_LAYER; conv_item(a, 1 + q / REST, CONV_TAIL_END + q % REST, scr, lane); }
    }
}

__device__ __forceinline__ void pro_mods(const Args& a, LAS unsigned char* lds, int bid, int nb, int tid) {
    LAS float* sl = (LAS float*)lds; LAS float* sc = sl + D; LAS float* red = sc + D;
    for (int i = tid; i < D; i += 512) { sl[i] = silu_f(a.in[I_C][i]); sc[i] = silu_f(a.in[I_CCTX][i]); }
    __syncthreads();
    const int cq = tid & 15, ks = tid >> 4;
    for (int it = bid; it < DEPTH * (NMODC / 64); it += nb) {
        const int l = it / (NMODC / 64), c0 = (it % (NMODC / 64)) * 64;
        const float* wp = a.in[I_ADAW] + ((size_t)l * D + ks * 64) * NMODC + c0 + 4 * cq;
        f32x4 al = {0.f, 0.f, 0.f, 0.f}, ac = {0.f, 0.f, 0.f, 0.f};
#pragma unroll 8
        for (int kk = 0; kk < 64; ++kk) { const f32x4 w = *(const f32x4*)(wp + (size_t)kk * NMODC); const float s1 = sl[ks * 64 + kk], s2 = sc[ks * 64 + kk]; al += w * s1; ac += w * s2; }
#pragma unroll
        for (int j = 0; j < 4; ++j) { red[(ks * 2 + 0) * 64 + cq * 4 + j] = al[j]; red[(ks * 2 + 1) * 64 + cq * 4 + j] = ac[j]; }
        __syncthreads();
        if (tid < 128) { const int which = tid >> 6, col = tid & 63; float s = a.in[I_ADAB][(size_t)l * NMODC + c0 + col];
            for (int k = 0; k < 32; ++k) s += red[(k * 2 + which) * 64 + col];
            ((float*)(a.ws + WS_MODS))[((size_t)l * 2 + which) * NMODC + c0 + col] = s; }
        __syncthreads();
    }
}

typedef float f32x16 __attribute__((ext_vector_type(16)));
__device__ __forceinline__ int accrow(int r, int h) { return (r & 3) + 8 * (r >> 2) + 4 * h; }
__device__ __forceinline__ float bf_hi(float x) { return __builtin_bit_cast(float, f2bf(x) << 16); }
__device__ __forceinline__ void pro_w4p(const Args& a, int gtid, int nthr) {
    for (int e = gtid; e < DEPTH * 64 * 4 * 64; e += nthr) {
        const int lane = e & 63, s_ = (e >> 6) & 3, cb = (e >> 8) & 63, l = e >> 14, i = lane & 31, h = lane >> 5;
        const float* w4 = a.in[I_FW4] + (size_t)l * 64 * 2048 + 32 * cb + i;
        unsigned hi[4], lo[4];
#pragma unroll
        for (int jj = 0; jj < 4; ++jj) { float v[2], vh[2], vl[2];
#pragma unroll
            for (int q = 0; q < 2; ++q) { const int j = 2 * jj + q, f = 32 * (s_ >> 1) + 16 * (s_ & 1) + 8 * (j >> 2) + 4 * h + (j & 3); v[q] = w4[(size_t)f * 2048]; vh[q] = bf_hi(v[q]); vl[q] = v[q] - vh[q]; }
            hi[jj] = f2bf(vh[0]) | (f2bf(vh[1]) << 16); lo[jj] = f2bf(vl[0]) | (f2bf(vl[1]) << 16); }
        v4u* dst = (v4u*)(a.ws + WS_W4P) + ((size_t)((l * 64 + cb) * 4 + s_) * 2) * 64 + lane;
        dst[0] = (v4u){hi[0], hi[1], hi[2], hi[3]}; dst[64] = (v4u){lo[0], lo[1], lo[2], lo[3]};
    }
}
__device__ __forceinline__ void pro_mods_wave(const Args& a, const LAS float* sl, const LAS float* sc, int widx, int nw, int lane) {
    const int cq = lane & 7, kp = lane >> 3;
    for (int it = widx; it < DEPTH * (NMODC / 32); it += nw) {
        const int l = it / (NMODC / 32), c0 = (it % (NMODC / 32)) * 32 + 4 * cq;
        const float* wp = a.in[I_ADAW] + ((size_t)l * D + kp) * NMODC + c0;
        f32x4 al = {0.f, 0.f, 0.f, 0.f}, ac = {0.f, 0.f, 0.f, 0.f};
#pragma unroll 16
        for (int kk = 0; kk < D / 8; ++kk) { const f32x4 w = *(const f32x4*)(wp + (size_t)kk * 8 * NMODC); const float s1 = sl[kp + 8 * kk], s2 = sc[kp + 8 * kk]; al += w * s1; ac += w * s2; }
#pragma unroll
        for (int j = 0; j < 4; ++j) {
#pragma unroll
            for (int o = 8; o < 64; o <<= 1) { al[j] += __shfl_xor(al[j], o); ac[j] += __shfl_xor(ac[j], o); } }
        if (lane < 8) { const f32x4 bb = *(const f32x4*)(a.in[I_ADAB] + (size_t)l * NMODC + c0);
            *(f32x4*)((float*)(a.ws + WS_MODS) + ((size_t)l * 2 + 0) * NMODC + c0) = al + bb; *(f32x4*)((float*)(a.ws + WS_MODS) + ((size_t)l * 2 + 1) * NMODC + c0) = ac + bb; }
    }
}
__device__ __forceinline__ void pro_filters(const Args& a, int bid, int nb, int wave, int lane, bool do_norm) {
    const int i = lane & 31, h = lane >> 5;
    for (int it = wave * nb + bid; it < DEPTH * 264; it += 8 * nb) {
        const int l = it / 264, q = it % 264, Lsel = q >= 256 ? 1 : 0, tile = Lsel ? q - 256 : q;
        const int L = Lsel ? CTX : SEQ, t = tile * 32 + i;
        const float tt = (float)t / (float)(L - 1), wv = 6.283185307179586f * (float)t / (float)L;
        const float* w1 = a.in[I_FW1] + l * 33 * 64; const float* b1 = a.in[I_FB1] + l * 64;
        const float* w2 = a.in[I_FW2] + l * 64 * 64; const float* b2 = a.in[I_FB2] + l * 64;
        const float* w3 = a.in[I_FW3] + l * 64 * 64; const float* b3 = a.in[I_FB3] + l * 64;
        const float* b4 = a.in[I_FB4] + l * 2048; const float* fr = a.in[I_FREQ] + l * 64;
        f32x16 c0, c1, d0, d1;
#pragma unroll
        for (int r = 0; r < 16; ++r) { c0[r] = b1[accrow(r, h)]; c1[r] = b1[32 + accrow(r, h)]; }
        float w1a[17], w1b[17];
        { int i1 = i; asm volatile("" : "+v"(i1));
#pragma unroll
          for (int s_ = 0; s_ < 17; ++s_) { const int k = 2 * s_ + h; w1a[s_] = k < 33 ? w1[k * 64 + i1] : 0.f; w1b[s_] = k < 33 ? w1[k * 64 + 32 + i1] : 0.f; } }
        __builtin_amdgcn_sched_barrier(0);
#pragma unroll
        for (int s_ = 0; s_ < 17; ++s_) {
            const int k = 2 * s_ + h; float z;
            if (s_ == 0) { z = h ? __cosf(wv * 1e-4f) : tt; }
            else { const int b = (k - 1) & 15; const float f = 1e-4f + (float)b * ((15.0f - 1e-4f) / 15.0f); z = (k <= 16) ? __cosf(wv * f) : -__sinf(wv * f); if (k > 32) z = 0.f; }
            c0 = __builtin_amdgcn_mfma_f32_32x32x2f32(w1a[s_], z, c0, 0, 0, 0); c1 = __builtin_amdgcn_mfma_f32_32x32x2f32(w1b[s_], z, c1, 0, 0, 0);
        }
#pragma unroll
        for (int r = 0; r < 16; ++r) { const int j = accrow(r, h); c0[r] = __sinf(fr[j] * c0[r]); c1[r] = __sinf(fr[32 + j] * c1[r]); }
#pragma unroll 1
        for (int layer = 0; layer < 2; ++layer) {
            const float* w = layer ? w3 : w2; const float* b = layer ? b3 : b2;
            int ii = i; asm volatile("" : "+v"(ii));
#pragma unroll
            for (int r = 0; r < 16; ++r) { d0[r] = b[accrow(r, h)]; d1[r] = b[32 + accrow(r, h)]; }
#pragma unroll
            for (int q4 = 0; q4 < 4; ++q4) {
                float wa[8], wb[8];
#pragma unroll
                for (int r = 0; r < 8; ++r) { const int kk = 32 * (q4 >> 1) + accrow(8 * (q4 & 1) + r, h); wa[r] = w[kk * 64 + ii]; wb[r] = w[kk * 64 + 32 + ii]; }
                __builtin_amdgcn_sched_barrier(0);
#pragma unroll
                for (int r = 0; r < 8; ++r) { const float cv = (q4 >> 1) ? c1[8 * (q4 & 1) + r] : c0[8 * (q4 & 1) + r]; d0 = __builtin_amdgcn_mfma_f32_32x32x2f32(wa[r], cv, d0, 0, 0, 0); d1 = __builtin_amdgcn_mfma_f32_32x32x2f32(wb[r], cv, d1, 0, 0, 0); }
                __builtin_amdgcn_sched_barrier(0);
            }
#pragma unroll
            for (int r = 0; r < 16; ++r) { const int j = accrow(r, h); c0[r] = __sinf(fr[j] * d0[r]); c1[r] = __sinf(fr[32 + j] * d1[r]); }
        }
        bf16x8 Bh[4], Bl[4];
#pragma unroll
        for (int s_ = 0; s_ < 4; ++s_) {
            unsigned wh[4], wl[4];
#pragma unroll
            for (int jj = 0; jj < 4; ++jj) { float v[2], vh[2];
#pragma unroll
                for (int q2 = 0; q2 < 2; ++q2) { const int r = 8 * (s_ & 1) + 2 * jj + q2; v[q2] = (s_ >> 1) ? c1[r] : c0[r]; vh[q2] = bf_hi(v[q2]); }
                wh[jj] = f2bf(vh[0]) | (f2bf(vh[1]) << 16); wl[jj] = f2bf(v[0] - vh[0]) | (f2bf(v[1] - vh[1]) << 16); }
            Bh[s_] = __builtin_bit_cast(bf16x8, (v4u){wh[0], wh[1], wh[2], wh[3]}); Bl[s_] = __builtin_bit_cast(bf16x8, (v4u){wl[0], wl[1], wl[2], wl[3]});
        }
        float* kT = Lsel ? (float*)(a.ws + WS_KTC) + (size_t)l * 2048 * CTX : (float*)(a.ws + WS_KT8) + (size_t)l * 2048 * SEQ;
        float* nrm = (float*)(a.ws + WS_NORM) + (size_t)(l * 2 + Lsel) * 2048;
        const v4u* w4p = (const v4u*)(a.ws + WS_W4P) + (size_t)l * 64 * 4 * 2 * 64 + lane;
        v4u nA[8]; float nbias[16];
        { const int cb = (it * 5) & 63;
#pragma unroll
          for (int q = 0; q < 8; ++q) nA[q] = w4p[(size_t)(cb * 8 + q) * 64];
#pragma unroll
          for (int r = 0; r < 16; ++r) nbias[r] = b4[32 * cb + accrow(r, h)]; }
#pragma unroll 1
        for (int cb_ = 0; cb_ < 64; ++cb_) {
            const int cb = (cb_ + it * 5) & 63;
            bf16x8 Ah[4], Al[4];
#pragma unroll
            for (int s_ = 0; s_ < 4; ++s_) { Ah[s_] = __builtin_bit_cast(bf16x8, nA[2 * s_]); Al[s_] = __builtin_bit_cast(bf16x8, nA[2 * s_ + 1]); }
            f32x16 acc;
#pragma unroll
            for (int r = 0; r < 16; ++r) acc[r] = nbias[r];
            { const int cbn = (cb_ + 1 + it * 5) & 63;
#pragma unroll
              for (int q = 0; q < 8; ++q) nA[q] = w4p[(size_t)(cbn * 8 + q) * 64];
#pragma unroll
              for (int r = 0; r < 16; ++r) nbias[r] = b4[32 * cbn + accrow(r, h)]; }
            __builtin_amdgcn_sched_barrier(0);
#pragma unroll
            for (int s_ = 0; s_ < 4; ++s_) {
                acc = __builtin_amdgcn_mfma_f32_32x32x16_bf16(Al[s_], Bh[s_], acc, 0, 0, 0);
                acc = __builtin_amdgcn_mfma_f32_32x32x16_bf16(Ah[s_], Bl[s_], acc, 0, 0, 0);
                acc = __builtin_amdgcn_mfma_f32_32x32x16_bf16(Ah[s_], Bh[s_], acc, 0, 0, 0);
            }
            const bool bwd = cb >= 32;
            float sv[16];
#pragma unroll
            for (int r = 0; r < 16; ++r) {
                const int col = 32 * cb + accrow(r, h), ch = col & 1023;
                const float delta = fabsf(-3.0701134573253944f + (float)ch * ((-15.350567286626972f + 3.0701134573253944f) / 1023.0f));
                const float kv = acc[r] * __expf(-tt * delta);
                kT[(size_t)col * L + t] = kv;
                sv[r] = (bwd && t == 0) ? 0.f : fabsf(kv);
            }
#pragma unroll
            for (int k = 0; k < 8; ++k) { const bool bit = (i >> 4) & 1; const float keep = bit ? sv[k + 8] : sv[k], send = bit ? sv[k] : sv[k + 8]; sv[k] = keep + __shfl_xor(send, 16); }
#pragma unroll
            for (int k = 0; k < 4; ++k) { const bool bit = (i >> 3) & 1; const float keep = bit ? sv[k + 4] : sv[k], send = bit ? sv[k] : sv[k + 4]; sv[k] = keep + __shfl_xor(send, 8); }
#pragma unroll
            for (int k = 0; k < 2; ++k) { const bool bit = (i >> 2) & 1; const float keep = bit ? sv[k + 2] : sv[k], send = bit ? sv[k] : sv[k + 2]; sv[k] = keep + __shfl_xor(send, 4); }
            { const bool bit = (i >> 1) & 1; const float keep = bit ? sv[1] : sv[0], send = bit ? sv[0] : sv[1]; sv[0] = keep + __shfl_xor(send, 2); }
            sv[0] += __shfl_xor(sv[0], 1);
            if (do_norm && (i & 1) == 0) unsafeAtomicAdd(nrm + 32 * cb + accrow((i >> 1) & 15, h), sv[0]);
        }
    }
}

constexpr int FFT_LDS_BYTES = (FFTN + FFTN / 16) * 8, FFT_TW_OFF = FFT_LDS_BYTES;
static_assert(FFT_TW_OFF + 192 * 8 <= LDS_CTLW, "FFT LDS map");
#define FA(i) ((i) + (((i) >> 6) << 2))
__device__ __forceinline__ void fft_tables(LAS f32x2* twh, LAS f32x2* twl, int tid) {
    if (tid < 64) { float s, c; sincospif(2.0f * (float)(tid * 128) / (float)FFTN, &s, &c); twh[tid] = (f32x2){c, -s}; }
    else if (tid < 192) { const int j = tid - 64; float s, c; sincospif(2.0f * (float)j / (float)FFTN, &s, &c); twl[j] = (f32x2){c, -s}; }
}
__device__ __forceinline__ f32x2 cmul(f32x2 a, f32x2 b) { return (f32x2){a.x * b.x - a.y * b.y, a.x * b.y + a.y * b.x}; }
__device__ __forceinline__ f32x2 cmulc(f32x2 a, f32x2 b) { return (f32x2){a.x * b.x + a.y * b.y, a.y * b.x - a.x * b.y}; }
__device__ __forceinline__ f32x2 twid(const LAS f32x2* twh, const LAS f32x2* twl, int j) { return cmul(twh[j >> 7], twl[j & 127]); }
__device__ __forceinline__ int brev14(int f) { return (int)(__brev((unsigned)f) >> 18); }
#define C16_C 0.92387953251128674f
#define C16_S 0.38268343236508977f
#define RH 0.70710678118654752f
__device__ __forceinline__ f32x2 c16(int jj) { switch (jj) { case 0: return (f32x2){1.f, 0.f}; case 1: return (f32x2){C16_C, -C16_S}; case 2: return (f32x2){RH, -RH}; case 3: return (f32x2){C16_S, -C16_C};
    case 4: return (f32x2){0.f, -1.f}; case 5: return (f32x2){-C16_S, -C16_C}; case 6: return (f32x2){-RH, -RH}; default: return (f32x2){-C16_C, -C16_S}; } }
__device__ __forceinline__ void r16_fwd(f32x2 (&v)[16], f32x2 t1) {
    const f32x2 t2 = cmul(t1, t1), t4 = cmul(t2, t2), t8 = cmul(t4, t4);
#pragma unroll
    for (int jj = 0; jj < 8; ++jj) { const f32x2 w = cmul(t1, c16(jj)); const f32x2 a = v[jj], c = v[jj + 8]; v[jj] = a + c; v[jj + 8] = cmul(a - c, w); }
#pragma unroll
    for (int jj = 0; jj < 4; ++jj) { const f32x2 w = cmul(t2, c16(2 * jj));
#pragma unroll
        for (int b = 0; b < 16; b += 8) { const f32x2 a = v[b + jj], c = v[b + jj + 4]; v[b + jj] = a + c; v[b + jj + 4] = cmul(a - c, w); } }
#pragma unroll
    for (int jj = 0; jj < 2; ++jj) { const f32x2 w = cmul(t4, c16(4 * jj));
#pragma unroll
        for (int b = 0; b < 16; b += 4) { const f32x2 a = v[b + jj], c = v[b + jj + 2]; v[b + jj] = a + c; v[b + jj + 2] = cmul(a - c, w); } }
#pragma unroll
    for (int b = 0; b < 16; b += 2) { const f32x2 a = v[b], c = v[b + 1]; v[b] = a + c; v[b + 1] = cmul(a - c, t8); }
}
__device__ __forceinline__ void r16_inv(f32x2 (&v)[16], f32x2 t1) {
    const f32x2 t2 = cmul(t1, t1), t4 = cmul(t2, t2), t8 = cmul(t4, t4);
#pragma unroll
    for (int b = 0; b < 16; b += 2) { const f32x2 a = v[b], c = cmulc(v[b + 1], t8); v[b] = a + c; v[b + 1] = a - c; }
#pragma unroll
    for (int jj = 0; jj < 2; ++jj) { const f32x2 w = cmul(t4, c16(4 * jj));
#pragma unroll
        for (int b = 0; b < 16; b += 4) { const f32x2 a = v[b + jj], c = cmulc(v[b + jj + 2], w); v[b + jj] = a + c; v[b + jj + 2] = a - c; } }
#pragma unroll
    for (int jj = 0; jj < 4; ++jj) { const f32x2 w = cmul(t2, c16(2 * jj));
#pragma unroll
        for (int b = 0; b < 16; b += 8) { const f32x2 a = v[b + jj], c = cmulc(v[b + jj + 4], w); v[b + jj] = a + c; v[b + jj + 4] = a - c; } }
#pragma unroll
    for (int jj = 0; jj < 8; ++jj) { const f32x2 w = cmul(t1, c16(jj)); const f32x2 a = v[jj], c = cmulc(v[jj + 8], w); v[jj] = a + c; v[jj + 8] = a - c; }
}
__device__ __forceinline__ void fft_store_p1(LAS f32x2* x, const f32x2 (&v)[16], int b) {
#pragma unroll
    for (int j = 0; j < 16; ++j) x[FA(b + 1024 * j)] = v[j];
}
__device__ __forceinline__ void fft_fwd_tail(LAS f32x2* x, const LAS f32x2* twh, const LAS f32x2* twl, int tid) {
    __syncthreads();
#pragma unroll
    for (int g = tid; g < 1024; g += 512) { const int hi = g >> 6, lo = g & 63, base = hi * 1024 + lo; f32x2 v[16];
#pragma unroll
        for (int j = 0; j < 16; ++j) v[j] = x[FA(base + 64 * j)];
        r16_fwd(v, twid(twh, twl, lo * 16));
#pragma unroll
        for (int j = 0; j < 16; ++j) x[FA(base + 64 * j)] = v[j]; }
    __syncthreads();
#pragma unroll
    for (int g = tid; g < 1024; g += 512) { const int hi = g >> 2, lo = g & 3, base = hi * 64 + lo; f32x2 v[16];
#pragma unroll
        for (int j = 0; j < 16; ++j) v[j] = x[FA(base + 4 * j)];
        r16_fwd(v, twid(twh, twl, lo * 256));
#pragma unroll
        for (int j = 0; j < 16; ++j) x[FA(base + 4 * j)] = v[j]; }
    __syncthreads();
#pragma unroll 2
    for (int g = tid; g < 4096; g += 512) { LAS f32x4* p = (LAS f32x4*)(x + FA(4 * g)); const f32x4 u0 = p[0], u1 = p[1];
        f32x2 v0 = {u0.x, u0.y}, v1 = {u0.z, u0.w}, v2 = {u1.x, u1.y}, v3 = {u1.z, u1.w};
        const f32x2 a0 = v0 + v2, a2 = v0 - v2, a1 = v1 + v3, d = v1 - v3, a3 = (f32x2){d.y, -d.x};
        v0 = a0 + a1; v1 = a0 - a1; v2 = a2 + a3; v3 = a2 - a3;
        p[0] = (f32x4){v0.x, v0.y, v1.x, v1.y}; p[1] = (f32x4){v2.x, v2.y, v3.x, v3.y}; }
    __syncthreads();
}
__device__ __forceinline__ void fft_inv_head(LAS f32x2* x, const LAS f32x2* twh, const LAS f32x2* twl, int tid) {
#pragma unroll 2
    for (int g = tid; g < 4096; g += 512) { LAS f32x4* p = (LAS f32x4*)(x + FA(4 * g)); const f32x4 u0 = p[0], u1 = p[1];
        f32x2 v0 = {u0.x, u0.y}, v1 = {u0.z, u0.w}, v2 = {u1.x, u1.y}, v3 = {u1.z, u1.w};
        const f32x2 a0 = v0 + v1, a1 = v0 - v1, a2 = v2 + v3, d = v2 - v3, a3 = (f32x2){-d.y, d.x};
        v0 = a0 + a2; v2 = a0 - a2; v1 = a1 + a3; v3 = a1 - a3;
        p[0] = (f32x4){v0.x, v0.y, v1.x, v1.y}; p[1] = (f32x4){v2.x, v2.y, v3.x, v3.y}; }
    __syncthreads();
#pragma unroll
    for (int g = tid; g < 1024; g += 512) { const int hi = g >> 2, lo = g & 3, base = hi * 64 + lo; f32x2 v[16];
#pragma unroll
        for (int j = 0; j < 16; ++j) v[j] = x[FA(base + 4 * j)];
        r16_inv(v, twid(twh, twl, lo * 256));
#pragma unroll
        for (int j = 0; j < 16; ++j) x[FA(base + 4 * j)] = v[j]; }
    __syncthreads();
#pragma unroll
    for (int g = tid; g < 1024; g += 512) { const int hi = g >> 6, lo = g & 63, base = hi * 1024 + lo; f32x2 v[16];
#pragma unroll
        for (int j = 0; j < 16; ++j) v[j] = x[FA(base + 64 * j)];
        r16_inv(v, twid(twh, twl, lo * 16));
#pragma unroll
        for (int j = 0; j < 16; ++j) x[FA(base + 64 * j)] = v[j]; }
    __syncthreads();
}

__device__ __forceinline__ void pro_fftk(const Args& a, LAS unsigned char* lds, int bid, int nb, int tid) {
    LAS f32x2* x = (LAS f32x2*)lds; LAS f32x2* twh = (LAS f32x2*)(lds + FFT_TW_OFF); LAS f32x2* twl = twh + 64;
    fft_tables(twh, twl, tid);
    __syncthreads();
    for (int it = bid; it < DEPTH * 512; it += nb) {
        const int l = it >> 9, p = it & 511, c1 = 2 * p, c2 = c1 + 1;
        const float* kT = (const float*)(a.ws + WS_KT8) + (size_t)l * 2048 * SEQ;
        const float* nrm = (const float*)(a.ws + WS_NORM) + (size_t)(l * 2) * 2048;
        const float i1 = 1.0f / (nrm[c1] + nrm[1024 + c1]), i2 = 1.0f / (nrm[c2] + nrm[1024 + c2]);
#pragma unroll
        for (int b = tid; b < 1024; b += 512) { f32x2 v[16];
#pragma unroll
            for (int j = 0; j < 8; ++j) v[j] = (f32x2){kT[(size_t)c1 * SEQ + b + 1024 * j] * i1, kT[(size_t)c2 * SEQ + b + 1024 * j] * i2};
#pragma unroll
            for (int j = 8; j < 16; ++j) { const int idx = b + 1024 * j;
                v[j] = idx == SEQ ? (f32x2){0.f, 0.f} : (f32x2){kT[(size_t)(1024 + c1) * SEQ + (FFTN - idx)] * i1, kT[(size_t)(1024 + c2) * SEQ + (FFTN - idx)] * i2}; }
            r16_fwd(v, twid(twh, twl, b));
            fft_store_p1(x, v, b); }
        fft_fwd_tail(x, twh, twl, tid);
        v2u* spec = (v2u*)(a.ws + WS_SPEC) + ((size_t)l * 512 + p) * SPEC_PITCH;
        const float sc = 0.5f;
        for (int pe = tid; pe <= FFTN / 2; pe += 512) {
            const int pp = pe < FFTN / 2 ? 2 * pe : 1, f = brev14(pp), qq = brev14((FFTN - f) & (FFTN - 1));
            const f32x2 zf = x[FA(pp)], zn = x[FA(qq)];
            const f32x2 k1 = (f32x2){0.5f * (zf.x + zn.x), 0.5f * (zf.y - zn.y)};
            const f32x2 dd = (f32x2){zf.x - zn.x, zf.y + zn.y};
            const f32x2 k2 = (f32x2){0.5f * dd.y, -0.5f * dd.x};
            spec[pe] = (v2u){pack_h2((k1.x + k2.x) * sc, (k1.y + k2.y) * sc), pack_h2((k1.x - k2.x) * sc, (k1.y - k2.y) * sc)};
        }
        __syncthreads();
    }
}

__device__ __forceinline__ void ph_norm(const Args& a, int l, int s, int nslab, int gw, int ngw, int lane) {
    xh* X = (xh*)(a.ws + WS_X); bf16* U = (bf16*)(a.ws + WS_U);
    const bool in_l = (l == 0 && s == 0), in_c = (l == 0 && s <= 1);
    const float* g = a.in[I_NORMG] + ((size_t)l * 3 + s) * D;
    const bool permute = (s == 1) && (l & 1);
    const int nbk = ngw >> 3, bidk = gw >> 3, wv = gw & 7;
    const bool ctxw = wv == 0;
    if (!ctxw && !in_l) {
        const float* mod = (const float*)(a.ws + WS_MODS) + (size_t)l * 2 * NMODC + (size_t)(3 * s) * D;
        f32x4 ga[4][2], sh[4][2];
#pragma unroll
        for (int j = 0; j < 4; ++j)
#pragma unroll
            for (int h = 0; h < 2; ++h) { const int c = 8 * lane + 512 * j + 4 * h; ga[j][h] = *(const f32x4*)(g + c) * (*(const f32x4*)(mod + D + c) + 1.0f); sh[j][h] = *(const f32x4*)(mod + c); }
        const int step = nbk * 7; int r = bidk * 7 + (wv - 1);
        h8 cur[4];
        if (r < SEQ) { const int src = permute ? (r & (GRID_R - 1)) * GRID_W + (r >> 7) : r; const h8* xr = (const h8*)(X + (size_t)src * D) + lane;
#pragma unroll
            for (int j = 0; j < 4; ++j) cur[j] = xr[64 * j]; }
        while (r < SEQ) {
            const int rn = r + step, rq = rn < SEQ ? rn : r; h8 nxt[4];
            { const int src = permute ? (rq & (GRID_R - 1)) * GRID_W + (rq >> 7) : rq; const h8* xr = (const h8*)(X + (size_t)src * D) + lane;
#pragma unroll
              for (int j = 0; j < 4; ++j) nxt[j] = xr[64 * j]; }
            f32x4 v[4][2]; float ss = 0.f;
#pragma unroll
            for (int j = 0; j < 4; ++j) { v[j][0] = __builtin_convertvector(__builtin_shufflevector(cur[j], cur[j], 0, 1, 2, 3), f32x4); v[j][1] = __builtin_convertvector(__builtin_shufflevector(cur[j], cur[j], 4, 5, 6, 7), f32x4);
#pragma unroll
                for (int h = 0; h < 2; ++h) ss += (v[j][h].x * v[j][h].x + v[j][h].y * v[j][h].y) + (v[j][h].z * v[j][h].z + v[j][h].w * v[j][h].w); }
            const float rs = rsqrtf(wave_sum(ss) * (1.0f / D) + EPS);
            bf16* o = U + (size_t)r * D + 8 * lane;
#pragma unroll
            for (int j = 0; j < 4; ++j) { const f32x4 y0 = v[j][0] * rs * ga[j][0] + sh[j][0], y1 = v[j][1] * rs * ga[j][1] + sh[j][1];
                st16_wt(o + 512 * j, (v4u){pk2(y0.x, y0.y), pk2(y0.z, y0.w), pk2(y1.x, y1.y), pk2(y1.z, y1.w)}); }
#pragma unroll
            for (int j = 0; j < 4; ++j) cur[j] = nxt[j];
            r = rn;
        }
        return;
    }
    for (int r = ctxw ? SEQ + bidk : bidk * 7 + (wv - 1); r < (ctxw ? MROWS : SEQ); r += ctxw ? nbk : nbk * 7) {
        const int which = r >= SEQ ? 1 : 0;
        const float* mod = (const float*)(a.ws + WS_MODS) + ((size_t)l * 2 + which) * NMODC + (size_t)(3 * s) * D;
        int src = r; if (permute && r < SEQ) src = (r & (GRID_R - 1)) * GRID_W + (r >> 7);
        f32x4 v[8]; float ss = 0.f;
        if (which ? in_c : in_l) { const f32x4* xr = (const f32x4*)((which ? a.in[I_CTX] - (size_t)SEQ * D : a.in[I_X]) + (size_t)src * D) + lane;
#pragma unroll
            for (int j = 0; j < 8; ++j) v[j] = xr[64 * j];
            if (!which) { h4* xw = (h4*)(X + (size_t)r * D) + lane;
#pragma unroll
                for (int j = 0; j < 8; ++j) xw[64 * j] = __builtin_convertvector(v[j], h4); }
        } else { const h4* xr = (const h4*)(X + (size_t)src * D) + lane; h4 t[8];
#pragma unroll
            for (int j = 0; j < 8; ++j) t[j] = xr[64 * j];
#pragma unroll
            for (int j = 0; j < 8; ++j) v[j] = __builtin_convertvector(t[j], f32x4); }
        if (which && nslab) {
            for (int k0 = 0; k0 < nslab; k0 += 6) { h4 sv[6][8];
#pragma unroll
                for (int kk = 0; kk < 6; ++kk) { const int k = k0 + kk < nslab ? k0 + kk : nslab - 1; const h4* sr = (const h4*)((const xh*)(a.ws + WS_SLAB) + ((size_t)k * CTX + (r - SEQ)) * D) + lane;
#pragma unroll
                    for (int j = 0; j < 8; ++j) sv[kk][j] = sr[64 * j]; }
#pragma unroll
                for (int kk = 0; kk < 6; ++kk) if (k0 + kk < nslab) {
#pragma unroll
                    for (int j = 0; j < 8; ++j) v[j] += __builtin_convertvector(sv[kk][j], f32x4); } }
            h4* xw = (h4*)(X + (size_t)r * D) + lane;
#pragma unroll
            for (int j = 0; j < 8; ++j) xw[64 * j] = __builtin_convertvector(v[j], h4);
        }
#pragma unroll
        for (int j = 0; j < 8; ++j) ss += (v[j].x * v[j].x + v[j].y * v[j].y) + (v[j].z * v[j].z + v[j].w * v[j].w);
        const float rs = rsqrtf(wave_sum(ss) * (1.0f / D) + EPS);
        v2u* o = (v2u*)(U + (size_t)r * D) + lane;
#pragma unroll
        for (int j = 0; j < 8; ++j) { const int c = 4 * lane + 256 * j; const f32x4 gg = *(const f32x4*)(g + c), sh = *(const f32x4*)(mod + c), scl = *(const f32x4*)(mod + D + c);
            const f32x4 y = v[j] * rs * gg * (scl + 1.0f) + sh;
            v2u w; w.x = pk2(y.x, y.y); w.y = pk2(y.z, y.w); o[64 * j] = w; }
    }
}

__device__ __forceinline__ void ph_convs(const Args& a, int l, LAS unsigned char* lds, int bid, int nb, int tid) {
    const bf16* P = (const bf16*)(a.ws + WS_P);
    LAS float* wt = (LAS float*)lds;
    const int cl = tid & 63, rg = tid >> 6;
    for (int it = bid; it < (SEQ / 64) * 8; it += nb) {
        const int rb = it >> 3, cb = it & 7, r0 = rb * 64, c = cb * 128 + 2 * cl;
        const int lo = rb >= SEQ / 64 ? SEQ : 0, hi = rb >= SEQ / 64 ? MROWS : SEQ;
        const int rs0 = r0 + rg * 8;
        unsigned ux[11], uh[3][10];
#pragma unroll
        for (int i = 0; i < 11; ++i) { const int r = rs0 - 1 + i, rc = r < lo ? lo : (r >= hi ? hi - 1 : r); ux[i] = *(const unsigned*)(P + (size_t)rc * IN_COLS + c); }
#pragma unroll
        for (int g = 0; g < 3; ++g)
#pragma unroll
            for (int i = 0; i < 10; ++i) { const int r = rs0 - 1 + i, rc = r < lo ? lo : (r >= hi ? hi - 1 : r); uh[g][i] = *(const unsigned*)(P + (size_t)rc * IN_COLS + 2048 + g * 1024 + c); }
        { const float* cw = a.in[I_LCW] + (size_t)l * 4 * 1024; const f32x2 w0 = *(const f32x2*)(cw + c), w1 = *(const f32x2*)(cw + 1024 + c), w2 = *(const f32x2*)(cw + 2048 + c), w3 = *(const f32x2*)(cw + 3072 + c), bb = *(const f32x2*)(a.in[I_LCB] + l * 1024 + c);
          f32x2 xv[11];
#pragma unroll
          for (int i = 0; i < 11; ++i) { const int r = rs0 - 1 + i; const unsigned u = (r >= lo && r < hi) ? ux[i] : 0u; xv[i] = (f32x2){bf_lo(u), bf_hi2(u)}; }
#pragma unroll
          for (int i = 0; i < 8; ++i) { const f32x2 cv = bb + w0 * xv[i] + w1 * xv[i + 1] + w2 * xv[i + 2] + w3 * xv[i + 3];
              *(unsigned*)((bf16*)(a.ws + WS_CVB) + (size_t)(rs0 + i) * 1024 + c) = pk2(cv.x, cv.y); } }
        f32x2 z[3][8];
#pragma unroll
        for (int g = 0; g < 3; ++g) { const int col = g * 1024 + c; const float* cw = a.in[I_HCW] + (size_t)l * 3 * 3072; const f32x2 w0 = *(const f32x2*)(cw + col), w1 = *(const f32x2*)(cw + 3072 + col), w2 = *(const f32x2*)(cw + 6144 + col), bb = *(const f32x2*)(a.in[I_HCB] + l * 3072 + col);
            f32x2 xv[10];
#pragma unroll
            for (int i = 0; i < 10; ++i) { const int r = rs0 - 1 + i; const unsigned u = (r >= lo && r < hi) ? uh[g][i] : 0u; xv[i] = (f32x2){bf_lo(u), bf_hi2(u)}; }
#pragma unroll
            for (int i = 0; i < 8; ++i) z[g][i] = bb + w0 * xv[i] + w1 * xv[i + 1] + w2 * xv[i + 2]; }
#pragma unroll
        for (int i = 0; i < 8; ++i) *(unsigned*)((bf16*)(a.ws + WS_X0) + (size_t)(rs0 + i) * 1024 + c) = pk2(z[0][i].x, z[0][i].y);
        {
#pragma unroll
            for (int i = 0; i < 8; ++i) { const f32x2 w = z[2][i] * z[1][i]; wt[(2 * cl) * 65 + rg * 8 + i] = w.x; wt[(2 * cl + 1) * 65 + rg * 8 + i] = w.y; }
            __syncthreads();
            { const int c2 = tid >> 2, seg = tid & 3; const LAS float* sp = wt + c2 * 65 + seg * 16;
              if (rb >= SEQ / 64) { float* dst = (float*)(a.ws + WS_WCTX) + (size_t)(cb * 128 + c2) * CTX + (r0 - SEQ) + seg * 16;
#pragma unroll
                  for (int k = 0; k < 4; ++k) *(f32x4*)(dst + 4 * k) = (f32x4){sp[4 * k], sp[4 * k + 1], sp[4 * k + 2], sp[4 * k + 3]}; }
              else { bf16* dst = (bf16*)(a.ws + WS_WT) + (size_t)(cb * 128 + c2) * SEQ + r0 + seg * 16;
#pragma unroll
                  for (int k = 0; k < 2; ++k) *(v4u*)(dst + 8 * k) = (v4u){pk2(sp[8 * k], sp[8 * k + 1]), pk2(sp[8 * k + 2], sp[8 * k + 3]), pk2(sp[8 * k + 4], sp[8 * k + 5]), pk2(sp[8 * k + 6], sp[8 * k + 7])}; } }
            __syncthreads();
        }
    }
    for (int sub = bid; sub < (CTX / 8) * 8; sub += nb) {
        const int rbs = sub >> 3, cb = sub & 7, c = cb * 128 + 2 * cl, row = SEQ + rbs * 8 + rg;
        unsigned ux[4], uh[3][3];
#pragma unroll
        for (int i = 0; i < 4; ++i) { const int r = row - 1 + i, rc = r < SEQ ? SEQ : (r >= MROWS ? MROWS - 1 : r); ux[i] = *(const unsigned*)(P + (size_t)rc * IN_COLS + c); }
#pragma unroll
        for (int g = 0; g < 3; ++g)
#pragma unroll
            for (int i = 0; i < 3; ++i) { const int r = row - 1 + i, rc = r < SEQ ? SEQ : (r >= MROWS ? MROWS - 1 : r); uh[g][i] = *(const unsigned*)(P + (size_t)rc * IN_COLS + 2048 + g * 1024 + c); }
        { const float* cw = a.in[I_LCW] + (size_t)l * 4 * 1024; f32x2 cv = *(const f32x2*)(a.in[I_LCB] + l * 1024 + c);
#pragma unroll
          for (int i = 0; i < 4; ++i) { const int r = row - 1 + i; const unsigned u = (r >= SEQ && r < MROWS) ? ux[i] : 0u; cv += *(const f32x2*)(cw + i * 1024 + c) * (f32x2){bf_lo(u), bf_hi2(u)}; }
          *(unsigned*)((bf16*)(a.ws + WS_CVB) + (size_t)row * 1024 + c) = pk2(cv.x, cv.y); }
        f32x2 z[3];
#pragma unroll
        for (int g = 0; g < 3; ++g) { const int col = g * 1024 + c; const float* cw = a.in[I_HCW] + (size_t)l * 3 * 3072; z[g] = *(const f32x2*)(a.in[I_HCB] + l * 3072 + col);
#pragma unroll
            for (int i = 0; i < 3; ++i) { const int r = row - 1 + i; const unsigned u = (r >= SEQ && r < MROWS) ? uh[g][i] : 0u; z[g] += *(const f32x2*)(cw + i * 3072 + col) * (f32x2){bf_lo(u), bf_hi2(u)}; } }
        *(unsigned*)((bf16*)(a.ws + WS_X0) + (size_t)row * 1024 + c) = pk2(z[0].x, z[0].y);
        { const f32x2 w = z[2] * z[1]; wt[(2 * cl) * 9 + rg] = w.x; wt[(2 * cl + 1) * 9 + rg] = w.y; }
        __syncthreads();
        if (tid < 256) { const int c2 = tid >> 1, hf = tid & 1; const LAS float* sp = wt + c2 * 9 + 4 * hf;
            *(f32x4*)((float*)(a.ws + WS_WCTX) + (size_t)(cb * 128 + c2) * CTX + rbs * 8 + 4 * hf) = (f32x4){sp[0], sp[1], sp[2], sp[3]}; }
        __syncthreads();
    }
}

__device__ __forceinline__ int scan_row(int d, int q, int i) {
    if (d == 0) return q < 8 ? SEQ + 32 * q + i : 32 * (q - 8) + i;
    return q < 8 ? SEQ + CTX - 1 - (32 * q + i) : SEQ - 1 - (32 * (q - 8) + i);
}
__device__ __forceinline__ void ph_scan1(const Args& a, int bid, int nb, int tid) {
    for (int it = bid; it < 2 * NCHUNK; it += nb) {
        const int q = it % NCHUNK, d = it / NCHUNK, ch = 2 * tid;
        const unsigned* AB = (const unsigned*)(a.ws + WS_ABP) + (size_t)d * MROWS * 1024 + ch;
        v2u w[32];
#pragma unroll
        for (int i = 0; i < 32; ++i) w[i] = *(const v2u*)(AB + (size_t)scan_row(d, q, i) * 1024);
        float l0 = 0.f, l1 = 0.f, s0 = 0.f, s1 = 0.f;
#pragma unroll
        for (int i = 0; i < 32; ++i) { const float la0 = h_lo(w[i].x), la1 = h_lo(w[i].y); l0 += la0; l1 += la1; s0 = lru_step(la0, h_hi(w[i].x), s0); s1 = lru_step(la1, h_hi(w[i].y), s1); }
        *(f32x2*)((float*)(a.ws + WS_SUMA) + ((size_t)d * NCHUNK + q) * 1024 + ch) = (f32x2){__expf(l0), __expf(l1)};
        *(f32x2*)((float*)(a.ws + WS_SUMB) + ((size_t)d * NCHUNK + q) * 1024 + ch) = (f32x2){s0, s1};
    }
}
__device__ __forceinline__ void ph_scan2(const Args& a, LAS unsigned char* lds, int bid, int tid) {
    if (bid >= 32) return;
    const int lane = tid & 63, wave = tid >> 6, gi = bid * 64 + lane, d = gi >> 10, ch = gi & 1023, q0 = 33 * wave;
    const float* SA = (const float*)(a.ws + WS_SUMA) + (size_t)d * NCHUNK * 1024 + ch; const float* SB = (const float*)(a.ws + WS_SUMB) + (size_t)d * NCHUNK * 1024 + ch;
    float* CY = (float*)(a.ws + WS_CARRY) + (size_t)d * NCHUNK * 1024 + ch;
    LAS float* gA = (LAS float*)lds; LAS float* gB = gA + 512;
    float sa[33], sb[33];
#pragma unroll
    for (int k = 0; k < 33; ++k) { sa[k] = SA[(size_t)(q0 + k) * 1024]; sb[k] = SB[(size_t)(q0 + k) * 1024]; }
    float pa = 1.f, pb = 0.f;
#pragma unroll
    for (int k = 0; k < 33; ++k) { pa *= sa[k]; pb = sa[k] * pb + sb[k]; }
    gA[wave * 64 + lane] = pa; gB[wave * 64 + lane] = pb;
    __syncthreads();
    float st = 0.f;
    for (int g = 0; g < wave; ++g) st = gA[g * 64 + lane] * st + gB[g * 64 + lane];
#pragma unroll
    for (int k = 0; k < 33; ++k) { CY[(size_t)(q0 + k) * 1024] = st; st = sa[k] * st + sb[k]; }
}
__device__ __forceinline__ void ph_ctxconv(const Args& a, int l, LAS unsigned char* lds, int first, int bid, int nb, int tid) {
    if (bid < first) return;
    const int lane = tid & 63, wave = tid >> 6;
    LAS float* kk = (LAS float*)lds + wave * 768;
    LAS float* wl = kk + 512;
    const float* KTC = (const float*)(a.ws + WS_KTC) + (size_t)l * 2048 * CTX; const float* nrm = (const float*)(a.ws + WS_NORM) + (size_t)(l * 2 + 1) * 2048;
    for (int c = (bid - first) * 8 + wave; c < 1024; c += (nb - first) * 8) {
        const float inv = 1.0f / (nrm[c] + nrm[1024 + c]);
        float wr[4];
#pragma unroll
        for (int j = 0; j < 4; ++j) { const int t = lane + 64 * j; wr[j] = ((const float*)(a.ws + WS_WCTX))[(size_t)c * CTX + t];
            kk[255 + t] = KTC[(size_t)c * CTX + t] * inv; if (t > 0) kk[255 - t] = KTC[(size_t)(1024 + c) * CTX + t] * inv; wl[t] = wr[j]; }
        LDS_WAIT(); asm volatile("" ::: "memory");
        float acc[4] = {0.f, 0.f, 0.f, 0.f};
#pragma unroll 4
        for (int s4 = 0; s4 < CTX; s4 += 4) { const f32x4 w4 = *(const LAS f32x4*)(wl + s4);
#pragma unroll
            for (int q = 0; q < 4; ++q) { const float wv = w4[q];
#pragma unroll
                for (int j = 0; j < 4; ++j) acc[j] = fmaf(kk[lane + 64 * j - (s4 + q) + 255], wv, acc[j]); } }
        const float hb = a.in[I_HBIAS][l * 1024 + c];
#pragma unroll
        for (int j = 0; j < 4; ++j) ((float*)(a.ws + WS_YCTX))[(size_t)c * CTX + lane + 64 * j] = acc[j] + hb * wr[j];
        LDS_WAIT(); asm volatile("" ::: "memory");
    }
}

__device__ __forceinline__ void ph_fftconv(const Args& a, int l, LAS unsigned char* lds, int bid, int nb, int tid) {
    LAS f32x2* x = (LAS f32x2*)lds; LAS f32x2* twh = (LAS f32x2*)(lds + FFT_TW_OFF); LAS f32x2* twl = twh + 64;
    fft_tables(twh, twl, tid);
    __syncthreads();
    for (int p = bid; p < 512; p += nb) {
        const bf16* w1 = (const bf16*)(a.ws + WS_WT) + (size_t)(2 * p) * SEQ; const bf16* w2 = w1 + SEQ;
        const v2u* spec = (const v2u*)(a.ws + WS_SPEC) + ((size_t)l * 512 + p) * SPEC_PITCH;
        v2u sp[16];
#pragma unroll
        for (int k = 0; k < 16; ++k) sp[k] = spec[tid + 512 * k];
        { unsigned u1[8], u2[8];
#pragma unroll
          for (int j = 0; j < 8; ++j) { u1[j] = *(const unsigned*)(w1 + 2 * tid + 1024 * j); u2[j] = *(const unsigned*)(w2 + 2 * tid + 1024 * j); }
#pragma unroll
          for (int e = 0; e < 2; ++e) { const int b = 2 * tid + e; f32x2 v[16];
#pragma unroll
            for (int j = 0; j < 8; ++j) v[j] = e ? (f32x2){bf_hi2(u1[j]), bf_hi2(u2[j])} : (f32x2){bf_lo(u1[j]), bf_lo(u2[j])};
#pragma unroll
            for (int j = 8; j < 16; ++j) v[j] = (f32x2){0.f, 0.f};
            r16_fwd(v, twid(twh, twl, b));
            fft_store_p1(x, v, b); } }
        fft_fwd_tail(x, twh, twl, tid);
#pragma unroll
        for (int k = 0; k <= 16; ++k) {
            const int pe = tid + 512 * k; if (k == 16 && tid != 0) break;
            const int pp = k < 16 ? 2 * pe : 1, f = brev14(pp), qq = brev14((FFTN - f) & (FFTN - 1));
            const v2u ab = k < 16 ? sp[k < 16 ? k : 0] : spec[FFTN / 2]; const f32x2 A = {h_lo(ab.x), h_hi(ab.x)}, B = {h_lo(ab.y), h_hi(ab.y)};
            const f32x2 zf = x[FA(pp)], zn = x[FA(qq)];
            const f32x2 yp = cmul(A, zf) + cmulc(B, zn);
            if (qq != pp) { const f32x2 cz = (f32x2){zf.x, -zf.y};
                const f32x2 yq = cmulc(zn, A) + (f32x2){B.x * cz.x + B.y * cz.y, B.x * cz.y - B.y * cz.x}; x[FA(qq)] = yq; }
            x[FA(pp)] = yp;
        }
        __syncthreads();
        fft_inv_head(x, twh, twl, tid);
        const float hb1 = a.in[I_HBIAS][l * 1024 + 2 * p], hb2 = a.in[I_HBIAS][l * 1024 + 2 * p + 1];
        bf16* y1 = (bf16*)(a.ws + WS_YT) + (size_t)(2 * p) * SEQ; bf16* y2 = y1 + SEQ;
        { unsigned u1[8], u2[8]; f32x2 yo[2][8];
#pragma unroll
          for (int j = 0; j < 8; ++j) { u1[j] = *(const unsigned*)(w1 + 2 * tid + 1024 * j); u2[j] = *(const unsigned*)(w2 + 2 * tid + 1024 * j); }
#pragma unroll
          for (int e = 0; e < 2; ++e) { const int b = 2 * tid + e; f32x2 v[16];
#pragma unroll
            for (int j = 0; j < 16; ++j) v[j] = x[FA(b + 1024 * j)];
            r16_inv(v, twid(twh, twl, b));
#pragma unroll
            for (int j = 0; j < 8; ++j) yo[e][j] = (f32x2){v[j].x * (1.0f / FFTN) + hb1 * (e ? bf_hi2(u1[j]) : bf_lo(u1[j])), v[j].y * (1.0f / FFTN) + hb2 * (e ? bf_hi2(u2[j]) : bf_lo(u2[j]))}; }
#pragma unroll
          for (int j = 0; j < 8; ++j) { *(unsigned*)(y1 + 2 * tid + 1024 * j) = pk2(yo[0][j].x, yo[1][j].x); *(unsigned*)(y2 + 2 * tid + 1024 * j) = pk2(yo[0][j].y, yo[1][j].y); } }
        __syncthreads();
    }
}

__device__ __forceinline__ void ph_merge(const Args& a, int l, LAS unsigned char* lds, int jlo, int jhi, int jstep, int tid, int part) {
    LAS float* T = (LAS float*)lds;
    const int lane = tid & 63, wave = tid >> 6;
    const bf16* P = (const bf16*)(a.ws + WS_P); bf16* U = (bf16*)(a.ws + WS_U);
    const float* og = a.in[I_OUTG] + (size_t)l * D;
    for (int j = jlo; j < jhi; j += jstep) {
        const bool isctx = j >= SEQ / 32; const int jc = j - SEQ / 32;
        const int r0 = isctx ? SEQ + 32 * jc : 32 * j, qf = isctx ? jc : 8 + j, qb = isctx ? 7 - jc : 8 + (SEQ / 32 - 1) - j;
        v4u yv[16];
        if (part == 0) {
#pragma unroll
            for (int idx = 0; idx < 16; ++idx) yv[idx] = (v4u){0u, 0u, 0u, 0u}; }
        else if (isctx) { const float* YT = (const float*)(a.ws + WS_YCTX) + (r0 - SEQ);
#pragma unroll
            for (int idx = 0; idx < 16; ++idx) { const int v_ = idx * 8 + wave, seg = v_ & 7, c = (v_ >> 3) * 64 + lane; yv[idx] = *(const v4u*)(YT + (size_t)c * CTX + 4 * seg); } }
        else { const bf16* YT = (const bf16*)(a.ws + WS_YT) + r0;
#pragma unroll
            for (int idx = 0; idx < 16; ++idx) { const int v_ = idx * 8 + wave, seg = v_ & 7, c = (v_ >> 3) * 64 + lane; const v2u q = *(const v2u*)(YT + (size_t)c * SEQ + 4 * seg);
                yv[idx] = (v4u){q.x, q.y, 0u, 0u}; } }
        if (part != 1) { const int ch = 2 * tid;
          float sf0, sf1, sb0, sb1;
          if (isctx) { sf0 = sf1 = sb0 = sb1 = 0.f;
              for (int q = 0; q < qf; ++q) { const f32x2 sa = *(const f32x2*)((const float*)(a.ws + WS_SUMA) + (size_t)q * 1024 + ch), sb = *(const f32x2*)((const float*)(a.ws + WS_SUMB) + (size_t)q * 1024 + ch); sf0 = sa.x * sf0 + sb.x; sf1 = sa.y * sf1 + sb.y; }
              for (int q = 0; q < qb; ++q) { const f32x2 sa = *(const f32x2*)((const float*)(a.ws + WS_SUMA) + ((size_t)NCHUNK + q) * 1024 + ch), sb = *(const f32x2*)((const float*)(a.ws + WS_SUMB) + ((size_t)NCHUNK + q) * 1024 + ch); sb0 = sa.x * sb0 + sb.x; sb1 = sa.y * sb1 + sb.y; } }
          else { const f32x2 cf = *(const f32x2*)((const float*)(a.ws + WS_CARRY) + (size_t)qf * 1024 + ch), cb = *(const f32x2*)((const float*)(a.ws + WS_CARRY) + ((size_t)NCHUNK + qb) * 1024 + ch); sf0 = cf.x; sf1 = cf.y; sb0 = cb.x; sb1 = cb.y; }
          const unsigned* ABf = (const unsigned*)(a.ws + WS_ABP) + (size_t)r0 * 1024 + ch; const unsigned* ABb = ABf + (size_t)MROWS * 1024;
#pragma unroll 1
          for (int hf_ = 0; hf_ < 2; ++hf_) { v2u w[16];
#pragma unroll
              for (int i = 0; i < 16; ++i) w[i] = *(const v2u*)(ABf + (size_t)(16 * hf_ + i) * 1024);
#pragma unroll
              for (int i = 0; i < 16; ++i) { sf0 = lru_step(h_lo(w[i].x), h_hi(w[i].x), sf0); sf1 = lru_step(h_lo(w[i].y), h_hi(w[i].y), sf1); *(LAS f32x2*)(T + (16 * hf_ + i) * 1024 + ch) = (f32x2){sf0, sf1}; } }
#pragma unroll 1
          for (int hf_ = 1; hf_ >= 0; --hf_) { v2u w[16]; unsigned yrw[16];
#pragma unroll
              for (int i = 0; i < 16; ++i) { w[i] = *(const v2u*)(ABb + (size_t)(16 * hf_ + i) * 1024); yrw[i] = *(const unsigned*)(P + (size_t)(r0 + 16 * hf_ + i) * IN_COLS + 1024 + ch); }
#pragma unroll
              for (int i = 15; i >= 0; --i) { sb0 = lru_step(h_lo(w[i].x), h_hi(w[i].x), sb0); sb1 = lru_step(h_lo(w[i].y), h_hi(w[i].y), sb1);
                  LAS f32x2* tp = (LAS f32x2*)(T + (16 * hf_ + i) * 1024 + ch); const f32x2 hf = *tp;
                  *tp = (f32x2){(hf.x + sb0) * gelu_tanh_f(bf_lo(yrw[i])), (hf.y + sb1) * gelu_tanh_f(bf_hi2(yrw[i]))}; } }
        }
        __syncthreads();
        if (part != 1) { f32x4 ogv[4];
#pragma unroll
          for (int k = 0; k < 4; ++k) ogv[k] = *(const f32x4*)(og + 4 * lane + 256 * k);
#pragma unroll
          for (int rr = 0; rr < 4; ++rr) { const int i = wave * 4 + rr; f32x4 v[4]; float ss = 0.f;
#pragma unroll
            for (int k = 0; k < 4; ++k) { v[k] = *(const LAS f32x4*)(T + i * 1024 + 4 * lane + 256 * k); ss += (v[k].x * v[k].x + v[k].y * v[k].y) + (v[k].z * v[k].z + v[k].w * v[k].w); }
            const float rs = rsqrtf(wave_sum(ss) * (1.0f / 1024.0f) + EPS);
#pragma unroll
            for (int k = 0; k < 4; ++k) { const int c = 4 * lane + 256 * k; const f32x4 y = v[k] * rs * ogv[k]; v2u w; w.x = pk2(y.x, y.y); w.y = pk2(y.z, y.w);
                *(v2u*)(U + (size_t)(r0 + i) * D + c) = w; } } }
        __syncthreads();
        if (part != 0) {
#pragma unroll
            for (int idx = 0; idx < 16; ++idx) { const int v_ = idx * 8 + wave, seg = v_ & 7, c = (v_ >> 3) * 64 + lane;
                const v4u q = yv[idx];
                const f32x4 y = isctx ? __builtin_bit_cast(f32x4, q) : (f32x4){bf_lo(q.x), bf_hi2(q.x), bf_lo(q.y), bf_hi2(q.y)};
                T[(4 * seg + 0) * 1024 + c] = y.x; T[(4 * seg + 1) * 1024 + c] = y.y; T[(4 * seg + 2) * 1024 + c] = y.z; T[(4 * seg + 3) * 1024 + c] = y.w; }
        }
        __syncthreads();
        if (part != 0) { f32x4 ogv[4]; v2u xw[4][4];
#pragma unroll
          for (int k = 0; k < 4; ++k) ogv[k] = *(const f32x4*)(og + 1024 + 4 * lane + 256 * k);
#pragma unroll
          for (int rr = 0; rr < 4; ++rr)
#pragma unroll
            for (int k = 0; k < 4; ++k) xw[rr][k] = *(const v2u*)((const bf16*)(a.ws + WS_X0) + (size_t)(r0 + wave * 4 + rr) * 1024 + 4 * lane + 256 * k);
#pragma unroll
          for (int rr = 0; rr < 4; ++rr) { const int i = wave * 4 + rr; f32x4 v[4]; float ss = 0.f;
#pragma unroll
            for (int k = 0; k < 4; ++k) { const v2u q = xw[rr][k]; v[k] = *(const LAS f32x4*)(T + i * 1024 + 4 * lane + 256 * k) * (f32x4){bf_lo(q.x), bf_hi2(q.x), bf_lo(q.y), bf_hi2(q.y)}; ss += (v[k].x * v[k].x + v[k].y * v[k].y) + (v[k].z * v[k].z + v[k].w * v[k].w); }
            const float rs = rsqrtf(wave_sum(ss) * (1.0f / 1024.0f) + EPS);
#pragma unroll
            for (int k = 0; k < 4; ++k) { const int c = 4 * lane + 256 * k; const f32x4 y = v[k] * rs * ogv[k]; v2u w; w.x = pk2(y.x, y.y); w.y = pk2(y.z, y.w);
                *(v2u*)(U + (size_t)(r0 + i) * D + 1024 + c) = w; } } }
        __syncthreads();
    }
}

__device__ __forceinline__ void ph_final(const Args& a, int gw, int ngw, int lane) {
    const xh* X = (const xh*)(a.ws + WS_X); const float* g = a.in[I_FINALG];
    for (int r = gw; r < SEQ; r += ngw) {
        const h4* xr = (const h4*)(X + (size_t)r * D) + lane; h4 t[8]; f32x4 v[8]; float ss = 0.f;
#pragma unroll
        for (int j = 0; j < 8; ++j) t[j] = xr[64 * j];
#pragma unroll
        for (int j = 0; j < 8; ++j) { v[j] = __builtin_convertvector(t[j], f32x4); ss += (v[j].x * v[j].x + v[j].y * v[j].y) + (v[j].z * v[j].z + v[j].w * v[j].w); }
        const float rs = rsqrtf(wave_sum(ss) * (1.0f / D) + EPS);
        f32x4* o = (f32x4*)(a.out + (size_t)r * D) + lane;
#pragma unroll
        for (int j = 0; j < 8; ++j) o[64 * j] = v[j] * rs * *(const f32x4*)(g + 4 * lane + 256 * j);
    }
}

__global__ void __launch_bounds__(512, 2) fwd_kernel(Args a) {
    extern __shared__ __attribute__((aligned(16))) unsigned char lds_raw[];
    LAS unsigned char* lds = (LAS unsigned char*)lds_raw;
    const int lo = a.ph_lo, hi = a.ph_hi;
#if MK_ONE_LAUNCH
    if (threadIdx.x < 16) ((LAS unsigned*)(lds + LDS_CTLW))[threadIdx.x] = 0u;
    __syncthreads();
    XcdBarrier bar = xcd_barrier_post((unsigned*)(a.ws + WS_CTL) + 4096, (volatile LAS unsigned*)(lds + LDS_CTLW));
#define GRID_BAR() xcd_barrier(bar)
#else
#define GRID_BAR() do { } while (0)
#endif
#ifndef DBG_ONLY
#define DBG_ONLY (-1)
#endif
#define EN(tag) (DBG_ONLY < 0 || DBG_ONLY == (tag))
#ifndef DBG_REP
#define DBG_REP 0
#endif
#define REP(tag) for (int rep_ = 0; rep_ < (((DBG_REP >> (tag)) & 1) ? 2 : 1); ++rep_)
#define IN(k) (lo <= (k) && (k) < hi)
#define FRESH() int tid = threadIdx.x; asm volatile("" : "+v"(tid)); const int lane = tid & 63, wave = __builtin_amdgcn_readfirstlane(tid >> 6); int bid = blockIdx.x; asm volatile("" : "+s"(bid)); const int nb = gridDim.x, gw = bid * 8 + wave, ngw = nb * 8; (void)lane; (void)gw; (void)ngw; (void)nb
#define SEAM(k) do { if (IN((k) + 1)) GRID_BAR(); } while (0)

    if (IN(PH_PRO0)) {
        FRESH();
        REP(0) if (EN(0)) pro_weights(a, lds, gw, ngw, wave, lane);
        for (int i = bid * 512 + tid; i < DEPTH * 2 * 1024; i += nb * 512) ((float*)(a.ws + WS_SP8))[i] = 8.0f * log1pf(expf(-a.in[I_LAM][i]));
        __syncthreads();
        pro_w4p(a, bid * 512 + tid, nb * 512);
        SEAM(PH_PRO0);
    }
    if (EN(2) && IN(PH_PRO1)) { FRESH();
        { LAS float* sl = (LAS float*)lds; LAS float* sc = sl + D;
          for (int i = tid; i < D; i += 512) { sl[i] = silu_f(a.in[I_C][i]); sc[i] = silu_f(a.in[I_CCTX][i]); }
          __syncthreads();
          if (wave >= 5) pro_mods_wave(a, sl, sc, (wave - 5) * nb + bid, 3 * nb + (nb - 32), lane);
          else if (wave == 4 && bid >= 32) pro_mods_wave(a, sl, sc, 3 * nb + (bid - 32), 3 * nb + (nb - 32), lane); }
        pro_filters(a, bid, nb, wave, lane, true);
        SEAM(PH_PRO1); }
    if (EN(3) && IN(PH_PRO2)) { FRESH(); __syncthreads(); REP(3) pro_fftk(a, lds, bid, nb, tid); SEAM(PH_PRO2); }

    for (int st = 0; st < DEPTH * 3; ++st) {
        int l = st / 3; const int kind = st % 3;
        const int base = PH_LAYER0 + PH_PER_LAYER * l + (kind == 0 ? 0 : kind == 1 ? 3 : 11);
        if (base >= hi || base + 8 <= lo) continue;
        const float* mods_l = (const float*)(a.ws + WS_MODS) + (size_t)l * 2 * NMODC; const float* mods_c = mods_l + NMODC;
        if (EN(4) && IN(base)) { FRESH(); REP(4) ph_norm(a, l, kind, rep_ ? 0 : (kind == 2 ? (l == DEPTH - 1 ? 0 : 8) : (kind == 0 && l == 0 ? 0 : 11)), gw, ngw, lane); SEAM(base); }
        if (kind != 1) {
            const int f = kind >> 1;
            if (EN(5) && IN(base + 1)) { FRESH();
                pg8::Gemm g{(const bf16*)(a.ws + WS_U), (const bf16*)(a.ws + WS_WUP) + (size_t)(l * 2 + f) * 2 * DFF * D, MROWS, 2 * DFF, D, D, D, 1 << 20, 0, 1 << 20, 0};
                pg8::StaticOrder S; S.init(MROWS, 2 * DFF, nb, bid, 1);
                unsigned* cnt = (unsigned*)(a.ws + WS_CTL + 32768) + 64 * (l * 2 + f);
                const bool need_ctx = !(l == DEPTH - 1 && kind == 2);
                EpiSwiGLU E{(bf16*)(a.ws + WS_H), cnt};
                pg8::gemm_phase<EpiSwiGLU>(lds, g, S, E);
                { const int ublk = S.nwg % nb;
                  if (ublk > 0 && bid >= ublk) {
                      if (need_ctx) {
                          if (tid == 0) { XB_SPIN(xb_ld(cnt) < 44u * 8u, (unsigned*)(a.ws + WS_CTL) + 4096); __builtin_amdgcn_fence(__ATOMIC_ACQUIRE, "agent"); asm volatile("s_waitcnt vmcnt(0)" ::: "memory"); }
                          __syncthreads();
                          pg8::Gemm g2{(const bf16*)(a.ws + WS_H) + (size_t)SEQ * DFF, (const bf16*)(a.ws + WS_WDN) + (size_t)(l * 2 + f) * D * DFF, CTX, D * 11, 512, DFF, DFF, 8, 512, 8, 512};
                          pg8::StaticOrder S2; S2.init(CTX, D * 11, nb - ublk, bid - ublk);
                          EpiSlab E2{(xh*)(a.ws + WS_SLAB), mods_c + (size_t)(3 * kind + 2) * D, 0.5f, 8};
                          pg8::gemm_phase<EpiSlab>(lds, g2, S2, E2);
                      }
                      if (l + 1 < DEPTH && bid >= ublk + 4) conv_range(a, lds, l + 1, kind == 0 ? CONV_T0 : CONV_T3, kind == 0 ? CONV_T1 : CONV_T4, (bid - ublk - 4) * 8 + wave, (nb - ublk - 4) * 8, wave, lane); } }
                SEAM(base + 1);
            }
            if (EN(6) && IN(base + 2)) { FRESH();
                { pg8::Gemm g{(const bf16*)(a.ws + WS_H), (const bf16*)(a.ws + WS_WDN) + (size_t)(l * 2 + f) * D * DFF, SEQ, D, DFF, DFF, DFF, 1 << 20, 0, 1 << 20, 0};
                  pg8::StaticOrder S; S.init(SEQ, D, nb, bid);
                  REP(6) { EpiResid E{(xh*)(a.ws + WS_X), mods_l + (size_t)(3 * kind + 2) * D, (((DBG_REP >> 6) & 1) && rep_ == 0) ? 0.0f : 0.5f, 0};
                  pg8::gemm_phase<EpiResid>(lds, g, S, E); } }
                SEAM(base + 2);
            }
        } else {
            if (EN(7) && IN(base + 1)) { FRESH();
                pg8::Gemm g{(const bf16*)(a.ws + WS_U), (const bf16*)(a.ws + WS_WIN) + (size_t)l * IN_COLS * D, MROWS, IN_COLS, D, D, D, 1 << 20, 0, 1 << 20, 0};
                pg8::StaticOrder S; S.init(MROWS, IN_COLS, nb, bid);
                EpiBf16Out E{(bf16*)(a.ws + WS_P), IN_COLS};
                REP(7) pg8::gemm_phase<EpiBf16Out>(lds, g, S, E);
                { const int ublk = S.nwg % nb;
                  if (l + 1 < DEPTH && ublk > 0 && bid >= ublk) conv_range(a, lds, l + 1, CONV_T1, CONV_T2, (bid - ublk) * 8 + wave, (nb - ublk) * 8, wave, lane); }
                SEAM(base + 1);
            }
            if (EN(8) && IN(base + 2)) { FRESH(); REP(8) ph_convs(a, l, lds, bid, nb, tid); SEAM(base + 2); }
            if (EN(9) && IN(base + 3)) { FRESH();
                pg8::Gemm g{(const bf16*)(a.ws + WS_CVB), (const bf16*)(a.ws + WS_WLRU) + (size_t)l * 4096 * 256, MROWS, 4096, 256, 1024, 256, 4, 256, 1 << 20, 0};
                pg8::StaticOrder S; S.init(MROWS, 4096, nb, bid);
                EpiGates E{a.in[I_BA] + (size_t)l * 2048, a.in[I_BX] + (size_t)l * 2048, (const float*)(a.ws + WS_SP8) + (size_t)l * 2048, (const bf16*)(a.ws + WS_CVB), (unsigned*)(a.ws + WS_ABP)};
                REP(9) pg8::gemm_phase<EpiGates>(lds, g, S, E);
                REP(15) ph_ctxconv(a, l, lds, 16, bid, nb, tid);
                SEAM(base + 3);
            }
            if (IN(base + 4)) { FRESH(); if (EN(10)) { REP(10) ph_scan1(a, bid, nb, tid); } __syncthreads(); if (EN(12)) { REP(12) ph_fftconv(a, l, lds, bid, nb, tid); } SEAM(base + 4); }
            if (EN(11) && IN(base + 5)) { FRESH(); REP(11) { ph_scan2(a, lds, bid, tid); if (bid >= 32 && bid < 48) { const int jc = (bid - 32) >> 1; ph_merge(a, l, lds, SEQ / 32 + jc, SEQ / 32 + jc + 1, 1, tid, (bid - 32) & 1); } __syncthreads(); }
                if (l + 1 < DEPTH && bid >= 48) conv_range(a, lds, l + 1, CONV_T2, CONV_T3, (bid - 48) * 8 + wave, (nb - 48) * 8, wave, lane);
                SEAM(base + 5); }
            if (EN(13) && IN(base + 6)) { FRESH(); __syncthreads(); REP(13) ph_merge(a, l, lds, bid, SEQ / 32, nb, tid, 2); SEAM(base + 6); }
            if (EN(14) && IN(base + 7)) { FRESH();
                { pg8::Gemm g{(const bf16*)(a.ws + WS_U), (const bf16*)(a.ws + WS_WOUT) + (size_t)l * D * D, SEQ, D, D, D, D, 1 << 20, 0, 1 << 20, 0};
                  pg8::StaticOrder S; S.init(SEQ, D, nb, bid);
                  REP(14) { EpiResid E{(xh*)(a.ws + WS_X), mods_l + (size_t)5 * D, (((DBG_REP >> 14) & 1) && rep_ == 0) ? 0.0f : 1.0f, l & 1};
                  pg8::gemm_phase<EpiResid>(lds, g, S, E); } }
                {
                  pg8::Gemm g{(const bf16*)(a.ws + WS_U) + (size_t)SEQ * D, (const bf16*)(a.ws + WS_WOUT) + (size_t)l * D * D, CTX, D * 8, 256, D, D, 8, 256, 8, 256};
                  pg8::StaticOrder S; S.init(CTX, D * 8, nb, bid);
                  EpiSlab E{(xh*)(a.ws + WS_SLAB), mods_c + (size_t)5 * D, 1.0f, 8};
                  REP(14) if (l != DEPTH - 1) pg8::gemm_phase<EpiSlab>(lds, g, S, E);
                  if (l + 1 < DEPTH && bid >= 64) conv_range(a, lds, l + 1, CONV_T5, CONV_T6, (bid - 64) * 8 + wave, (nb - 64) * 8, wave, lane); }
                SEAM(base + 7);
            }
        }
    }
    if (EN(15) && IN(PH_FINAL)) { FRESH(); ph_final(a, gw, ngw, lane); }
#undef IN
#undef SEAM
}

extern "C" void kernel_launch(void* const* d_in, const int* in_sizes, int n_in, void* d_out, int out_size, void* d_ws, size_t ws_size, hipStream_t stream) {
    static int grid = 0;
    if (grid == 0) {
        if (n_in != N_IN || out_size != SEQ * D || ws_size < WS_END) { fprintf(stderr, "kernel_launch: unexpected shapes (n_in %d, out %d, ws %zu < %zu); nothing launched\n", n_in, out_size, ws_size, (size_t)WS_END); grid = -1; return; }
        int dev = 0, cus = 0, per_cu = 0;
        if (hipGetDevice(&dev) != hipSuccess || hipDeviceGetAttribute(&cus, hipDeviceAttributeMultiprocessorCount, dev) != hipSuccess) { grid = -1; return; }
        if (hipFuncSetAttribute((const void*)fwd_kernel, hipFuncAttributeMaxDynamicSharedMemorySize, LDS_BYTES) != hipSuccess) { fprintf(stderr, "kernel_launch: hipFuncSetAttribute failed\n"); grid = -1; return; }
        if (hipOccupancyMaxActiveBlocksPerMultiprocessor(&per_cu, (const void*)fwd_kernel, 512, LDS_BYTES) != hipSuccess || per_cu < 1) fprintf(stderr, "kernel_launch: occupancy query says %d blocks per CU\n", per_cu);
        (void)hipGetLastError();
        grid = cus;
    }
    if (grid < 0) return;
    (void)in_sizes;
    Args a{};
    for (int i = 0; i < N_IN; ++i) a.in[i] = (const float*)d_in[i];
    a.out = (float*)d_out; a.ws = (unsigned char*)d_ws;
    (void)hipMemsetAsync((char*)d_ws + WS_CTL, 0, 131072, stream);
#if MK_ONE_LAUNCH
    a.ph_lo = 0; a.ph_hi = N_PHASES;
    hipLaunchKernelGGL(fwd_kernel, dim3(grid), dim3(512), LDS_BYTES, stream, a);
#else
    for (int ph = 0; ph < N_PHASES; ++ph) { a.ph_lo = ph; a.ph_hi = ph + 1; hipLaunchKernelGGL(fwd_kernel, dim3(grid), dim3(512), LDS_BYTES, stream, a); }
#endif
}
```

```cpp
#include <hip/hip_runtime.h>
#include <cstdio>
#include <cstdint>

#ifndef MK_ONE_LAUNCH
#define MK_ONE_LAUNCH 1
#endif

#define GAS __attribute__((address_space(1)))
#define LAS __attribute__((address_space(3)))
typedef unsigned short bf16;
typedef unsigned v4u __attribute__((ext_vector_type(4)));
typedef unsigned v2u __attribute__((ext_vector_type(2)));
typedef float f32x4 __attribute__((ext_vector_type(4)));
typedef float f32x2 __attribute__((ext_vector_type(2)));
typedef short bf16x8 __attribute__((ext_vector_type(8)));
typedef _Float16 xh;
typedef _Float16 h4 __attribute__((ext_vector_type(4)));
typedef _Float16 h8 __attribute__((ext_vector_type(8)));

constexpr int D = 2048, SEQ = 8192, CTX = 256, MROWS = SEQ + CTX, DEPTH = 4, DFF = 5632;
constexpr int LRU_W = 1024, HY_W = 1024, IN_COLS = 5120, NMODC = 9 * D;
constexpr int GRID_W = 64, GRID_R = SEQ / GRID_W;
constexpr int FFTN = 16384, SPEC_PITCH = 8200;
constexpr float EPS = 1e-6f;
constexpr int NCHUNK = MROWS / 32;

constexpr size_t al256(size_t x) { return (x + 255) & ~(size_t)255; }
constexpr size_t WS_CTL = 0, CTL_BYTES = 1u << 20;
constexpr size_t WS_WUP = WS_CTL + CTL_BYTES;
constexpr size_t WS_WDN = WS_WUP + (size_t)DEPTH * 2 * 2 * DFF * D * 2;
constexpr size_t WS_WIN = WS_WDN + (size_t)DEPTH * 2 * D * DFF * 2;
constexpr size_t WS_WOUT = WS_WIN + (size_t)DEPTH * IN_COLS * D * 2;
constexpr size_t WS_WLRU = WS_WOUT + (size_t)DEPTH * D * D * 2;
constexpr size_t WS_MODS = WS_WLRU + (size_t)DEPTH * 4096 * 256 * 2;
constexpr size_t WS_SP8 = al256(WS_MODS + (size_t)DEPTH * 2 * NMODC * 4);
constexpr size_t WS_KTC = WS_SP8 + (size_t)DEPTH * 2 * 1024 * 4;
constexpr size_t WS_W4P = WS_KTC + (size_t)DEPTH * 2048 * 256 * 4;
constexpr size_t WS_SPEC = WS_W4P + (size_t)DEPTH * 64 * 4 * 2 * 64 * 16;
constexpr size_t WS_NORM = WS_CTL + 65536;
constexpr size_t WS_X = WS_SPEC + (size_t)DEPTH * 512 * SPEC_PITCH * 8;
constexpr size_t WS_U = WS_X + (size_t)MROWS * D * 4;
constexpr size_t WS_H = WS_U + (size_t)MROWS * D * 2;
constexpr size_t WS_CARRY = WS_H + (size_t)MROWS * DFF * 2;
constexpr size_t WS_SUMA = WS_CARRY + (size_t)2 * NCHUNK * 1024 * 4;
constexpr size_t WS_SUMB = WS_SUMA + (size_t)2 * NCHUNK * 1024 * 4;
constexpr size_t WS_WCTX = WS_SUMB + (size_t)2 * NCHUNK * 1024 * 4;
constexpr size_t WS_YCTX = WS_WCTX + (size_t)CTX * 1024 * 4;
constexpr size_t WS_SLAB = WS_YCTX + (size_t)CTX * 1024 * 4;
constexpr size_t WS_BIG = WS_SLAB + (size_t)11 * CTX * D * 4;
constexpr size_t WS_KT8 = WS_BIG;
constexpr size_t WS_P = WS_BIG;
constexpr size_t WS_CVF = WS_P + (size_t)MROWS * IN_COLS * 2;
constexpr size_t WS_CVB = WS_CVF + (size_t)MROWS * 1024 * 4;
constexpr size_t WS_X0 = WS_CVB + (size_t)MROWS * 1024 * 2;
constexpr size_t WS_WT = WS_X0 + (size_t)MROWS * 1024 * 4;
constexpr size_t WS_YT = WS_WT + (size_t)1024 * SEQ * 2;
constexpr size_t WS_ABP = WS_YT + (size_t)1024 * SEQ * 2;
constexpr size_t WS_END_ACT = WS_ABP + (size_t)2 * MROWS * 1024 * 4;
constexpr size_t WS_END_KT8 = WS_KT8 + (size_t)DEPTH * 2048 * 8192 * 4;
constexpr size_t WS_END = WS_END_ACT > WS_END_KT8 ? WS_END_ACT : WS_END_KT8;
static_assert(WS_END < (size_t)2300 * 1000 * 1000, "workspace map exceeds the guaranteed d_ws size");

constexpr int LDS_MAIN = 131072, LDS_BYTES = 147456;
constexpr int LDS_EXTRA = LDS_MAIN, LDS_CTLW = LDS_BYTES - 64;

namespace pg8 {
typedef unsigned short bf16_t;
typedef unsigned u32x4 __attribute__((ext_vector_type(4)));
constexpr int BM = 256, BK = 64, HALF = 128, HTB = HALF * BK * 2, STAGE_BYTES = 8 * HTB, NXCD = 8, WGM = 8;
__host__ __device__ __forceinline__ int lds_byte(int r, int c) { const int st = (r >> 4) * 2 + (c >> 5), rr = r & 15, cc = c & 31, ob = rr * 64 + cc * 2; return st * 1024 + (ob ^ (((ob >> 9) & 1) << 5)); }
__host__ __device__ __forceinline__ void stage_rc(int b, int& R, int& C) { const int st = b / 1024, sb = b % 1024, swz = sb ^ (((sb >> 9) & 1) << 5); R = (st >> 1) * 16 + swz / 64; C = (st & 1) * 32 + (swz % 64) / 2; }
__host__ __device__ __forceinline__ int perm32(int rho) { const int n = rho >> 4, i = rho & 15; return 8 * (i >> 2) + 4 * n + (i & 3); }
struct Unit { int pm, pn; };
struct Gemm { const bf16_t* A; const bf16_t* Bt; int M, N, K, lda, ldb, agrp_n, agrp_off, bmod, bgrp_off; };
struct StaticOrder {
    int nM, nN, nwg, G, c, rev;
    __host__ __device__ void init(int M, int N, int G_, int c_, int rev_ = 0) { nM = M / BM; nN = N / BM; nwg = nM * nN; G = G_; c = c_; rev = rev_; }
    __host__ __device__ bool next(int i, Unit& u) const {
        const long L = (long)i * G + c; if (L >= nwg) return false;
        int wgid = (int)L; { const int q = nwg / NXCD, r = nwg % NXCD, xcd = wgid % NXCD; int off = wgid / NXCD; if (rev) off = (xcd < r ? q + 1 : q) - 1 - off;
            wgid = (xcd < r ? xcd * (q + 1) : r * (q + 1) + (xcd - r) * q) + off; }
        const int nig = WGM * nN, gid = wgid / nig, fm = gid * WGM, gsz = (nM - fm) < WGM ? (nM - fm) : WGM;
        u.pm = fm + ((wgid % nig) % gsz); u.pn = (wgid % nig) / gsz; return true;
    }
};
__device__ __forceinline__ unsigned cvt_pk_bf16(float lo, float hi) { unsigned r; asm volatile("v_cvt_pk_bf16_f32 %0, %1, %2" : "=v"(r) : "v"(lo), "v"(hi)); return r; }

#ifndef PG8_SP2
#define PG8_SP2 true
#endif
template <class Epi, bool ALIGN_EPI = true, bool SP2 = PG8_SP2>
__device__ __forceinline__ void gemm_phase(LAS unsigned char* lds, const Gemm g, const StaticOrder& S, const Epi& E) {
    int tid = threadIdx.x; asm volatile("" : "+v"(tid));
    const int wid = __builtin_amdgcn_readfirstlane(tid >> 6), lane = tid & 63, wr = wid >> 2, wc = wid & 3, fr = lane & 15, fq = lane >> 4;
    const int K = g.K, nt = K / BK;
    unsigned voffA[2], voffB[2];
#pragma unroll
    for (int i = 0; i < 2; ++i) { int R, C; stage_rc(tid * 16 + i * 8192, R, C); const int Rb = Epi::PERM ? ((R & ~31) + perm32(R & 31)) : R;
        voffA[i] = (unsigned)(R * g.lda + C) * 2u; voffB[i] = (unsigned)(Rb * g.ldb + C) * 2u; }
    const size_t kstep = (size_t)(BK * 2);
    const size_t hstepA = (size_t)HALF * g.lda * 2, hstepB = (size_t)HALF * g.ldb * 2;
    const size_t tstepA = 2 * hstepA, tstepB = 2 * hstepB;
    const unsigned ldsw = (unsigned)wid * 1024u;
    const int aoff = lds_byte(wr * 64 + fr, fq * 8), boff = lds_byte(wc * 32 + fr, fq * 8);
#define PG8_SA(b, h) (((b) * 2 + (h)) * HTB)
#define PG8_SB(b, h) ((4 + (b) * 2 + (h)) * HTB)
#define PG8_STAGE(bufoff, gbase, voff) do { _Pragma("unroll") for (int _i = 0; _i < 2; ++_i) \
        __builtin_amdgcn_global_load_lds((const GAS unsigned*)((const char*)(gbase) + (voff)[_i]), (LAS unsigned*)(lds + (bufoff) + ldsw + _i * 8192), 16, 0, 0); } while (0)
#define PG8_LDA(dst, b, h) do { _Pragma("unroll") for (int m = 0; m < 4; ++m) _Pragma("unroll") for (int k = 0; k < 2; ++k) dst[m][k] = *(const LAS bf16x8*)(lds + PG8_SA(b, h) + aoff + m * 2048 + k * 1024); } while (0)
#define PG8_LDB(dst, b, h) do { _Pragma("unroll") for (int n = 0; n < 2; ++n) _Pragma("unroll") for (int k = 0; k < 2; ++k) dst[n][k] = *(const LAS bf16x8*)(lds + PG8_SB(b, h) + boff + n * 2048 + k * 1024); } while (0)
#define PG8_MMA(ai, bj, At, Bt) do { __builtin_amdgcn_s_setprio(1); _Pragma("unroll") for (int m = 0; m < 4; ++m) _Pragma("unroll") for (int n = 0; n < 2; ++n) _Pragma("unroll") for (int k = 0; k < 2; ++k) \
        acc[ai][bj][m][n] = __builtin_amdgcn_mfma_f32_16x16x32_bf16(Bt[n][k], At[m][k], acc[ai][bj][m][n], 0, 0, 0); __builtin_amdgcn_s_setprio(0); } while (0)
#define PG8_WAIT_V(n) asm volatile("s_waitcnt vmcnt(" #n ")" ::: "memory")
#define PG8_WAIT_L(n) asm volatile("s_waitcnt lgkmcnt(" #n ")" ::: "memory")
#define PG8_BAR __builtin_amdgcn_s_barrier()
#define PG8_SCHED __builtin_amdgcn_sched_barrier(0)
    Unit cur, nxt; int ui = 0;
    if (!S.next(0, cur)) return;
    f32x4 acc[2][2][4][2];
#pragma unroll
    for (int a = 0; a < 2; ++a)
#pragma unroll
        for (int b = 0; b < 2; ++b)
#pragma unroll
            for (int m = 0; m < 4; ++m)
#pragma unroll
                for (int n = 0; n < 2; ++n) acc[a][b][m][n] = (f32x4){0.f, 0.f, 0.f, 0.f};
    bf16x8 At[4][2], B0[2][2], B1[2][2];
    const char* cA = (const char*)g.A + (size_t)cur.pm * tstepA + (size_t)((cur.pn / g.agrp_n) * g.agrp_off) * 2; const char* cB = (const char*)g.Bt + (size_t)(cur.pn % g.bmod) * tstepB + (size_t)((cur.pn / g.bmod) * g.bgrp_off) * 2;
    if constexpr (SP2) {
    PG8_STAGE(PG8_SB(0, 0), cB, voffB); PG8_STAGE(PG8_SB(0, 1), cB + hstepB, voffB); PG8_STAGE(PG8_SA(0, 0), cA, voffA); PG8_STAGE(PG8_SA(0, 1), cA + hstepA, voffA);
    if (wr == 1) PG8_BAR;
    PG8_WAIT_V(2); PG8_BAR;
    PG8_STAGE(PG8_SB(1, 0), cB + kstep, voffB); PG8_STAGE(PG8_SA(1, 0), cA + kstep, voffA); PG8_STAGE(PG8_SB(1, 1), cB + hstepB + kstep, voffB);
    PG8_WAIT_V(6); PG8_BAR;
    } else {
    PG8_STAGE(PG8_SB(0, 0), cB, voffB); PG8_STAGE(PG8_SA(0, 0), cA, voffA); PG8_STAGE(PG8_SB(0, 1), cB + hstepB, voffB); PG8_STAGE(PG8_SA(0, 1), cA + hstepA, voffA);
    if (wr == 1) PG8_BAR;
    PG8_WAIT_V(4); PG8_BAR;
    PG8_STAGE(PG8_SB(1, 0), cB + kstep, voffB); PG8_STAGE(PG8_SA(1, 0), cA + kstep, voffA); PG8_STAGE(PG8_SB(1, 1), cB + hstepB + kstep, voffB);
    PG8_WAIT_V(6); PG8_BAR;
    }
    for (;;) {
        const bool has_next = S.next(ui + 1, nxt);
        const char* nA = has_next ? (const char*)g.A + (size_t)nxt.pm * tstepA + (size_t)((nxt.pn / g.agrp_n) * g.agrp_off) * 2 : cA;
        const char* nB = has_next ? (const char*)g.Bt + (size_t)(nxt.pn % g.bmod) * tstepB + (size_t)((nxt.pn / g.bmod) * g.bgrp_off) * 2 : cB;
#pragma unroll 1
        for (int t = 0; t < nt; t += 2) {
            const bool last = (t == nt - 2);
            const char* a1 = cA + (size_t)(t + 1) * kstep;
            const char* a2 = last ? nA : cA + (size_t)(t + 2) * kstep; const char* b2 = last ? nB : cB + (size_t)(t + 2) * kstep;
            const char* a3 = a2 + kstep; const char* b3 = b2 + kstep;
            if constexpr (SP2) {
            PG8_LDB(B0, 0, 0); PG8_LDB(B1, 0, 1); PG8_SCHED; PG8_LDA(At, 0, 0); PG8_STAGE(PG8_SA(1, 1), a1 + hstepA, voffA);
            PG8_WAIT_V(8); PG8_WAIT_L(0); PG8_BAR; PG8_MMA(0, 0, At, B0); PG8_MMA(0, 1, At, B1); PG8_BAR; PG8_SCHED;
            PG8_LDA(At, 0, 1); PG8_STAGE(PG8_SB(0, 0), b2, voffB); PG8_STAGE(PG8_SB(0, 1), b2 + hstepB, voffB); PG8_STAGE(PG8_SA(0, 0), a2, voffA);
            PG8_WAIT_V(8); PG8_WAIT_L(0); PG8_BAR; PG8_MMA(1, 0, At, B0); PG8_MMA(1, 1, At, B1); PG8_BAR; PG8_SCHED;
            PG8_LDB(B0, 1, 0); PG8_LDB(B1, 1, 1); PG8_SCHED; PG8_LDA(At, 1, 0); PG8_STAGE(PG8_SA(0, 1), a2 + hstepA, voffA);
            PG8_WAIT_V(8); PG8_WAIT_L(0); PG8_BAR; PG8_MMA(0, 0, At, B0); PG8_MMA(0, 1, At, B1); PG8_BAR; PG8_SCHED;
            PG8_LDA(At, 1, 1); PG8_STAGE(PG8_SB(1, 0), b3, voffB); PG8_STAGE(PG8_SB(1, 1), b3 + hstepB, voffB); PG8_STAGE(PG8_SA(1, 0), a3, voffA);
            PG8_WAIT_V(8); PG8_WAIT_L(0); PG8_BAR; PG8_MMA(1, 0, At, B0); PG8_MMA(1, 1, At, B1); PG8_BAR; PG8_SCHED;
            } else {
            PG8_LDB(B0, 0, 0); PG8_SCHED; PG8_LDA(At, 0, 0); PG8_STAGE(PG8_SA(1, 1), a1 + hstepA, voffA);
            PG8_WAIT_L(8); PG8_BAR; PG8_WAIT_L(0); PG8_MMA(0, 0, At, B0); PG8_BAR; PG8_SCHED;
            PG8_LDB(B1, 0, 1); PG8_STAGE(PG8_SB(0, 0), b2, voffB);
            PG8_BAR; PG8_WAIT_L(0); PG8_MMA(0, 1, At, B1); PG8_BAR;
            PG8_LDA(At, 0, 1); PG8_STAGE(PG8_SA(0, 0), a2, voffA);
            PG8_BAR; PG8_WAIT_L(0); PG8_MMA(1, 0, At, B0); PG8_BAR; PG8_SCHED;
            PG8_STAGE(PG8_SB(0, 1), b2 + hstepB, voffB);
            PG8_WAIT_V(6); PG8_BAR; PG8_MMA(1, 1, At, B1); PG8_BAR;
            PG8_LDB(B0, 1, 0); PG8_SCHED; PG8_LDA(At, 1, 0); PG8_STAGE(PG8_SA(0, 1), a2 + hstepA, voffA);
            PG8_WAIT_L(8); PG8_BAR; PG8_WAIT_L(0); PG8_MMA(0, 0, At, B0); PG8_BAR; PG8_SCHED;
            PG8_LDB(B1, 1, 1); PG8_STAGE(PG8_SB(1, 0), b3, voffB);
            PG8_BAR; PG8_WAIT_L(0); PG8_MMA(0, 1, At, B1); PG8_BAR;
            PG8_LDA(At, 1, 1); PG8_STAGE(PG8_SA(1, 0), a3, voffA);
            PG8_BAR; PG8_WAIT_L(0); PG8_MMA(1, 0, At, B0); PG8_BAR; PG8_SCHED;
            PG8_STAGE(PG8_SB(1, 1), b3 + hstepB, voffB);
            PG8_WAIT_V(6); PG8_BAR; PG8_MMA(1, 1, At, B1); PG8_BAR;
            }
        }
        if constexpr (ALIGN_EPI) { if (wr == 0) PG8_BAR; }
        E(acc, cur, wr, wc, fr, fq);
#ifdef DBG_EPI2
        if (Epi::PERM) { asm volatile("s_waitcnt vmcnt(0)" ::: "memory"); E(acc, cur, wr, wc, fr, fq); }
#endif
        if (!has_next) break;
#pragma unroll
        for (int a = 0; a < 2; ++a)
#pragma unroll
            for (int b = 0; b < 2; ++b)
#pragma unroll
                for (int m = 0; m < 4; ++m)
#pragma unroll
                    for (int n = 0; n < 2; ++n) acc[a][b][m][n] = (f32x4){0.f, 0.f, 0.f, 0.f};
        cur = nxt; cA = nA; cB = nB; ++ui;
        if constexpr (ALIGN_EPI) { if (wr == 1) PG8_BAR; }
    }
    PG8_WAIT_V(0);
    if constexpr (!ALIGN_EPI) { if (wr == 0) PG8_BAR; }
    PG8_BAR;
#undef PG8_SA
#undef PG8_SB
#undef PG8_STAGE
#undef PG8_LDA
#undef PG8_LDB
#undef PG8_MMA
#undef PG8_WAIT_V
#undef PG8_WAIT_L
#undef PG8_BAR
#undef PG8_SCHED
}
}

__device__ __forceinline__ unsigned f2bf(float f) { unsigned u = __builtin_bit_cast(unsigned, f); return (u + 0x7fffu + ((u >> 16) & 1u)) >> 16; }
__device__ __forceinline__ unsigned pk2(float lo, float hi) { return f2bf(lo) | (f2bf(hi) << 16); }
__device__ __forceinline__ float sigmoid_f(float x) { return 1.0f / (1.0f + __expf(-x)); }
__device__ __forceinline__ float silu_f(float x) { return x / (1.0f + __expf(-x)); }
__device__ __forceinline__ float gelu_tanh_f(float x) { const float u = 0.7978845608028654f * (x + 0.044715f * x * x * x); const float th = 1.0f - 2.0f * __builtin_amdgcn_rcpf(1.0f + __expf(2.0f * u)); return 0.5f * x * (1.0f + th); }
__device__ __forceinline__ float wave_sum(float v) {
#pragma unroll
    for (int o = 1; o < 64; o <<= 1) v += __shfl_xor(v, o);
    return v;
}
#define LDS_WAIT() asm volatile("s_waitcnt lgkmcnt(0)" ::: "memory")
__device__ __forceinline__ unsigned pack_h2(float lo, float hi) { const _Float16 a = (_Float16)lo, b = (_Float16)hi; return (unsigned)__builtin_bit_cast(unsigned short, a) | ((unsigned)__builtin_bit_cast(unsigned short, b) << 16); }
__device__ __forceinline__ float h_lo(unsigned w) { return (float)__builtin_bit_cast(_Float16, (unsigned short)(w & 0xffffu)); }
__device__ __forceinline__ float lru_step(float la, float bp, float h) { const float a = __expf(la); return a * h + __builtin_amdgcn_sqrtf(fmaxf(1.0f - a * a, 0.f)) * bp; }
__device__ __forceinline__ float h_hi(unsigned w) { return (float)__builtin_bit_cast(_Float16, (unsigned short)(w >> 16)); }
__device__ __forceinline__ float bf_lo(unsigned w) { return __builtin_bit_cast(float, w << 16); }
__device__ __forceinline__ float bf_hi2(unsigned w) { return __builtin_bit_cast(float, w & 0xffff0000u); }

__device__ __forceinline__ void st16_wt(void* p, v4u v) { asm volatile("global_store_dwordx4 %0, %1, off sc1\n\ts_nop 1" ::"v"(p), "v"(v) : "memory"); }
struct EpiSwiGLU {
    static constexpr bool PERM = true;
    bf16* H; unsigned* cnt;
    __device__ __forceinline__ void operator()(const f32x4 (&acc)[2][2][4][2], const pg8::Unit& u, int wr, int wc, int fr, int fq) const {
        const int row0 = u.pm * 256 + wr * 64 + fr, col0 = u.pn * 128 + wc * 32 + 8 * fq;
#pragma unroll
        for (int ai = 0; ai < 2; ++ai)
#pragma unroll
            for (int m = 0; m < 4; ++m) {
                bf16* rowp = H + (size_t)(row0 + ai * 128 + m * 16) * DFF + col0;
                float o[8];
#pragma unroll
                for (int n = 0; n < 2; ++n)
#pragma unroll
                    for (int j = 0; j < 4; ++j) { const float gv = acc[ai][0][m][n][j], uv = acc[ai][1][m][n][j]; o[n * 4 + j] = gv * __builtin_amdgcn_rcpf(1.0f + __expf(-gv)) * uv; }
                v4u w; w.x = pg8::cvt_pk_bf16(o[0], o[1]); w.y = pg8::cvt_pk_bf16(o[2], o[3]); w.z = pg8::cvt_pk_bf16(o[4], o[5]); w.w = pg8::cvt_pk_bf16(o[6], o[7]);
                st16_wt(rowp, w);
            }
        if (u.pm == MROWS / 256 - 1) {
            asm volatile("s_waitcnt vmcnt(0)" ::: "memory");
            if ((fr | fq) == 0) (void)__hip_atomic_fetch_add(cnt, 1u, __ATOMIC_RELAXED, __HIP_MEMORY_SCOPE_AGENT);
        }
    }
};
struct EpiResid {
    static constexpr bool PERM = true;
    xh* X; const float* gate_l; float sc; int permute;
    __device__ __forceinline__ void operator()(const f32x4 (&acc)[2][2][4][2], const pg8::Unit& u, int wr, int wc, int fr, int fq) const {
        const int row0 = u.pm * 256 + wr * 64 + fr, col0 = u.pn * 256 + wc * 32 + 8 * fq;
        f32x4 gv[2][2];
#pragma unroll
        for (int bj = 0; bj < 2; ++bj)
#pragma unroll
            for (int n = 0; n < 2; ++n) gv[bj][n] = *(const f32x4*)(gate_l + col0 + bj * 128 + n * 4) * sc;
#pragma unroll
        for (int ai = 0; ai < 2; ++ai) {
            xh* rowp[4]; h8 xv[4][2];
#pragma unroll
            for (int m = 0; m < 4; ++m) { int row = row0 + ai * 128 + m * 16; if (permute && row < SEQ) row = (row & (GRID_R - 1)) * GRID_W + (row >> 7); rowp[m] = X + (size_t)row * D + col0; }
#pragma unroll
            for (int m = 0; m < 4; ++m)
#pragma unroll
                for (int bj = 0; bj < 2; ++bj) xv[m][bj] = *(const h8*)(rowp[m] + bj * 128);
#pragma unroll
            for (int m = 0; m < 4; ++m)
#pragma unroll
                for (int bj = 0; bj < 2; ++bj) {
                    const f32x4 lo = __builtin_convertvector(__builtin_shufflevector(xv[m][bj], xv[m][bj], 0, 1, 2, 3), f32x4) + gv[bj][0] * acc[ai][bj][m][0];
                    const f32x4 hi = __builtin_convertvector(__builtin_shufflevector(xv[m][bj], xv[m][bj], 4, 5, 6, 7), f32x4) + gv[bj][1] * acc[ai][bj][m][1];
                    const h4 l4 = __builtin_convertvector(lo, h4), h4v = __builtin_convertvector(hi, h4);
                    const h8 o8 = __builtin_shufflevector(l4, h4v, 0, 1, 2, 3, 4, 5, 6, 7);
                    st16_wt(rowp[m] + bj * 128, __builtin_bit_cast(v4u, o8));
                }
        }
    }
};
struct EpiSlab {
    static constexpr bool PERM = false;
    xh* S; const float* gate; float sc; int ntile;
    __device__ __forceinline__ void operator()(const f32x4 (&acc)[2][2][4][2], const pg8::Unit& u, int wr, int wc, int fr, int fq) const {
        const int row0 = u.pm * 256 + wr * 64 + fr, col0 = (u.pn % ntile) * 256 + wc * 32 + 4 * fq;
        xh* base = S + (size_t)(u.pn / ntile) * CTX * D;
#pragma unroll
        for (int bj = 0; bj < 2; ++bj)
#pragma unroll
            for (int n = 0; n < 2; ++n) { const f32x4 gv = *(const f32x4*)(gate + col0 + bj * 128 + n * 16) * sc;
#pragma unroll
                for (int ai = 0; ai < 2; ++ai)
#pragma unroll
                    for (int m = 0; m < 4; ++m) *(h4*)(base + (size_t)(row0 + ai * 128 + m * 16) * D + col0 + bj * 128 + n * 16) = __builtin_convertvector(gv * acc[ai][bj][m][n], h4); }
    }
};
struct EpiBf16Out {
    static constexpr bool PERM = true;
    bf16* O; int ldc;
    __device__ __forceinline__ void operator()(const f32x4 (&acc)[2][2][4][2], const pg8::Unit& u, int wr, int wc, int fr, int fq) const {
        const int row0 = u.pm * 256 + wr * 64 + fr, col0 = u.pn * 256 + wc * 32 + 8 * fq;
#pragma unroll
        for (int ai = 0; ai < 2; ++ai)
#pragma unroll
            for (int m = 0; m < 4; ++m) { bf16* rowp = O + (size_t)(row0 + ai * 128 + m * 16) * ldc + col0;
#pragma unroll
                for (int bj = 0; bj < 2; ++bj) { const f32x4 v0 = acc[ai][bj][m][0], v1 = acc[ai][bj][m][1];
                    v4u w; w.x = pg8::cvt_pk_bf16(v0[0], v0[1]); w.y = pg8::cvt_pk_bf16(v0[2], v0[3]); w.z = pg8::cvt_pk_bf16(v1[0], v1[1]); w.w = pg8::cvt_pk_bf16(v1[2], v1[3]);
                    st16_wt(rowp + bj * 128, w); } }
    }
};
struct EpiF32 {
    static constexpr bool PERM = false;
    float* C; int ldc;
    __device__ __forceinline__ void operator()(const f32x4 (&acc)[2][2][4][2], const pg8::Unit& u, int wr, int wc, int fr, int fq) const {
        const int row0 = u.pm * 256 + wr * 64 + fr, col0 = u.pn * 256 + wc * 32 + 4 * fq;
#pragma unroll
        for (int ai = 0; ai < 2; ++ai)
#pragma unroll
            for (int m = 0; m < 4; ++m) { float* rowp = C + (size_t)(row0 + ai * 128 + m * 16) * ldc + col0;
#pragma unroll
                for (int bj = 0; bj < 2; ++bj)
#pragma unroll
                    for (int n = 0; n < 2; ++n) *(f32x4*)(rowp + bj * 128 + n * 16) = acc[ai][bj][m][n]; }
    }
};
struct EpiGates {
    static constexpr bool PERM = false;
    const float* ba; const float* bx; const float* sp8;
    const bf16* cvb; unsigned* ABP;
    __device__ __forceinline__ void operator()(const f32x4 (&acc)[2][2][4][2], const pg8::Unit& u, int wr, int wc, int fr, int fq) const {
        const int head = u.pn >> 2, d = (u.pn >> 1) & 1, c2 = u.pn & 1;
        const int row0 = u.pm * 256 + wr * 64 + fr, ch0 = head * 256 + c2 * 128 + wc * 32 + 4 * fq;
        v2u cvw[2][2][4];
#pragma unroll
        for (int n = 0; n < 2; ++n)
#pragma unroll
            for (int ai = 0; ai < 2; ++ai)
#pragma unroll
                for (int m = 0; m < 4; ++m) cvw[n][ai][m] = *(const v2u*)(cvb + (size_t)(row0 + ai * 128 + m * 16) * 1024 + ch0 + n * 16);
#pragma unroll
        for (int n = 0; n < 2; ++n) {
            const f32x4 vba = *(const f32x4*)(ba + d * 1024 + ch0 + n * 16), vbx = *(const f32x4*)(bx + d * 1024 + ch0 + n * 16), vsp = *(const f32x4*)(sp8 + d * 1024 + ch0 + n * 16);
#pragma unroll
            for (int ai = 0; ai < 2; ++ai)
#pragma unroll
                for (int m = 0; m < 4; ++m) {
                    const size_t off = (size_t)(row0 + ai * 128 + m * 16) * 1024 + ch0 + n * 16;
                    const v2u cw = cvw[n][ai][m]; const f32x4 cv = {bf_lo(cw.x), bf_hi2(cw.x), bf_lo(cw.y), bf_hi2(cw.y)};
                    v4u pk;
#pragma unroll
                    for (int j = 0; j < 4; ++j) {
                        const float za = fminf(fmaxf(acc[ai][0][m][n][j] + vba[j], -60.f), 60.f), zx = fminf(fmaxf(acc[ai][1][m][n][j] + vbx[j], -60.f), 60.f);
                        const float pa = 1.0f + __expf(-za), px = 1.0f + __expf(-zx), rp = __builtin_amdgcn_rcpf(pa * px);
                        const float r = px * rp, ig = pa * rp;
                        const float la = -r * vsp[j];
                        pk[j] = pack_h2(la, ig * cv[j]);
                    }
                    st16_wt(ABP + (size_t)d * MROWS * 1024 + off, pk);
                }
        }
    }
};

#define XB_TMO      128
#define XB_XCNT(j)  (256  + 64 * (j))
#define XB_XSUB(j)  (1280 + 64 * (j))
#define XB_XGEN(j)  (2304 + 64 * (j))
#define XB_TOP      3328
#define XB_TOPGEN   3392
#define XCD_BAR_WORDS 3456
#define XB_SPIN_CAP (1u << 18)
__device__ __forceinline__ unsigned xb_ld(unsigned* p)              { return __hip_atomic_load(p, __ATOMIC_RELAXED, __HIP_MEMORY_SCOPE_AGENT); }
__device__ __forceinline__ unsigned xb_add(unsigned* p, unsigned v) { return __hip_atomic_fetch_add(p, v, __ATOMIC_RELAXED, __HIP_MEMORY_SCOPE_AGENT); }
__device__ __forceinline__ unsigned xb_xcc_id() { return (unsigned)__builtin_amdgcn_s_getreg((3 << 11) | 20) & 0xFu; }
#define XB_SPIN(cond, bar) do { unsigned _sp = 0; while (cond) { __builtin_amdgcn_s_sleep(1); \
    if ((++_sp & 255u) == 0u) { if (xb_ld(&(bar)[XB_TMO])) break; if (_sp > XB_SPIN_CAP) { atomicAdd(&(bar)[XB_TMO], 1u); break; } } } } while (0)
struct XcdBarrier { unsigned* bar; unsigned x; volatile LAS unsigned* st; };
__device__ __forceinline__ XcdBarrier xcd_barrier_post(unsigned* bar, volatile LAS unsigned* st) {
    XcdBarrier b; b.bar = bar; b.x = xb_xcc_id(); b.st = st;
    if (threadIdx.x == 0) (void)xb_add(&bar[XB_XCNT(b.x)], 1u);
    return b;
}
__device__ __forceinline__ void xcd_barrier_complete(unsigned* bar, unsigned x, unsigned& nloc, unsigned& nx) {
    const unsigned G = gridDim.x * gridDim.y * gridDim.z;
    unsigned sum, cnt, mine, sp = 0u;
    for (;;) {
        sum = 0u; cnt = 0u; mine = 0u;
#pragma unroll
        for (unsigned j = 0; j < 16; ++j) { const unsigned c = xb_ld(&bar[XB_XCNT(j)]); sum += c; cnt += (c > 0u) ? 1u : 0u; mine = (j == x) ? c : mine; }
        if (sum == G) break;
        __builtin_amdgcn_s_sleep(1);
        if ((++sp & 255u) == 0u) { if (xb_ld(&bar[XB_TMO])) break; if (sp > XB_SPIN_CAP) { atomicAdd(&bar[XB_TMO], 1u); break; } }
    }
    nloc = mine > 0u ? mine : 1u; nx = cnt > 0u ? cnt : 1u;
}
__device__ __forceinline__ void xcd_barrier(const XcdBarrier& b) {
    asm volatile("s_waitcnt vmcnt(0)" ::: "memory");
    __syncthreads();
    if (threadIdx.x == 0) {
        unsigned* bar = b.bar;
        __builtin_amdgcn_s_waitcnt(0);
        unsigned nloc = b.st[0], nx = b.st[1];
        if (nloc == 0u) { xcd_barrier_complete(bar, b.x, nloc, nx); b.st[0] = nloc; b.st[1] = nx; }
        const unsigned old = xb_add(&bar[XB_XSUB(b.x)], 1u);
        const unsigned gen = old / nloc;
        if (old + 1u == (gen + 1u) * nloc) {
            __builtin_amdgcn_fence(__ATOMIC_RELEASE, "agent");
            asm volatile("s_waitcnt vmcnt(0)" ::: "memory");
            const unsigned og = xb_add(&bar[XB_TOP], 1u);
            const unsigned tg = og / nx;
            if (og + 1u == (tg + 1u) * nx) xb_add(&bar[XB_TOPGEN], 1u);
            else XB_SPIN(xb_ld(&bar[XB_TOPGEN]) == tg, bar);
            __builtin_amdgcn_fence(__ATOMIC_ACQUIRE, "agent");
            xb_add(&bar[XB_XGEN(b.x)], 1u);
            asm volatile("s_waitcnt vmcnt(0)" ::: "memory");
        } else {
            XB_SPIN(xb_ld(&bar[XB_XGEN(b.x)]) == gen, bar);
            __builtin_amdgcn_fence(__ATOMIC_ACQUIRE, "agent");
            asm volatile("s_waitcnt vmcnt(0)" ::: "memory");
        }
    }
    __syncthreads();
}

enum InIdx { I_X = 0, I_C, I_CTX, I_CCTX, I_ADAW, I_ADAB, I_NORMG, I_WG, I_WU, I_WD, I_WIN, I_WOUT, I_OUTG, I_LCW, I_LCB, I_WA, I_BA, I_WX, I_BX, I_LAM,
             I_HCW, I_HCB, I_HBIAS, I_FW1, I_FB1, I_FW2, I_FB2, I_FW3, I_FB3, I_FW4, I_FB4, I_FREQ, I_FINALG, N_IN };
struct Args { const float* in[N_IN]; float* out; unsigned char* ws; int ph_lo, ph_hi; };
static_assert(sizeof(Args) == (N_IN + 2) * 8 + 8, "Args has no padding");

constexpr int PH_PRO0 = 0, PH_PRO1 = 1, PH_PRO2 = 2, PH_LAYER0 = 3, PH_PER_LAYER = 14, PH_FINAL = PH_LAYER0 + DEPTH * PH_PER_LAYER, N_PHASES = PH_FINAL + 1;

__device__ __forceinline__ void transpose_item(const float* W, int N, bf16* WT, int ldk, int dest_row0, int k0, int n0, LAS float* scr, int lane) {
    float wv_[32];
#pragma unroll
    for (int i = 0; i < 32; ++i) wv_[i] = W[(size_t)(k0 + 2 * i + (lane >> 5)) * N + n0 + (lane & 31)];
#pragma unroll
    for (int i = 0; i < 32; ++i) scr[(2 * i + (lane >> 5)) * 33 + (lane & 31)] = wv_[i];
    LDS_WAIT(); asm volatile("" ::: "memory");
    const int c = lane & 7;
#pragma unroll
    for (int j = 0; j < 4; ++j) { const int n = (lane >> 3) + 8 * j; const LAS float* s = scr + (8 * c) * 33 + n;
        v4u o; o.x = pk2(s[0 * 33], s[1 * 33]); o.y = pk2(s[2 * 33], s[3 * 33]); o.z = pk2(s[4 * 33], s[5 * 33]); o.w = pk2(s[6 * 33], s[7 * 33]);
        *(v4u*)(WT + (size_t)(dest_row0 + n) * ldk + k0 + 8 * c) = o; }
    LDS_WAIT(); asm volatile("" ::: "memory");
}

constexpr int CONV_UP = 4 * 32 * 176, CONV_DN = 2 * 88 * 64, CONV_IN = 32 * 160, CONV_OUT = 32 * 64, CONV_LRU = 16 * 32, CONV_PER_LAYER = CONV_UP + CONV_DN + CONV_IN + CONV_OUT + CONV_LRU;
constexpr int CONV_T_UP = 80 * 8 * 4, CONV_T_WIN = 108 * 8 * 10, CONV_T_SC = 208 * 8 * 3, CONV_T_DN = 0, CONV_T_WO = 192 * 8 * 3;
constexpr int CONV_T0 = 0, CONV_T1 = CONV_T0 + CONV_T_UP, CONV_T2 = CONV_T1 + CONV_T_WIN, CONV_T3 = CONV_T2 + CONV_T_SC, CONV_T4 = CONV_T3 + CONV_T_UP;
constexpr int CONV_T5 = CONV_T4 + CONV_T_DN, CONV_T6 = CONV_T5 + CONV_T_WO, CONV_TAIL_END = CONV_T6 + CONV_T_DN;
static_assert(CONV_PER_LAYER == 41472 && CONV_TAIL_END <= CONV_PER_LAYER, "conversion item map");
__device__ __forceinline__ void conv_item(const Args& a, int l, int r, LAS float* scr, int lane) {
    if (r < CONV_UP) { const int mat = r / 5632, q = r % 5632, kb = q / 176, nb = q % 176, lf = l * 2 + (mat >> 1), g = mat & 1, n0 = 32 * nb;
        transpose_item((g ? a.in[I_WU] : a.in[I_WG]) + (size_t)lf * D * DFF, DFF, (bf16*)(a.ws + WS_WUP) + (size_t)lf * 2 * DFF * D, D, 256 * (n0 >> 7) + 128 * g + (n0 & 127), 64 * kb, n0, scr, lane); return; }
    r -= CONV_UP;
    if (r < CONV_DN) { const int mat = l * 2 + r / 5632, q = r % 5632, kb = q / 64, nb = q % 64;
        transpose_item(a.in[I_WD] + (size_t)mat * DFF * D, D, (bf16*)(a.ws + WS_WDN) + (size_t)mat * D * DFF, DFF, 32 * nb, 64 * kb, 32 * nb, scr, lane); return; }
    r -= CONV_DN;
    if (r < CONV_IN) { const int kb = r / 160, nb = r % 160;
        transpose_item(a.in[I_WIN] + (size_t)l * D * IN_COLS, IN_COLS, (bf16*)(a.ws + WS_WIN) + (size_t)l * IN_COLS * D, D, 32 * nb, 64 * kb, 32 * nb, scr, lane); return; }
    r -= CONV_IN;
    if (r < CONV_OUT) { const int kb = r / 64, nb = r % 64;
        transpose_item(a.in[I_WOUT] + (size_t)l * D * D, D, (bf16*)(a.ws + WS_WOUT) + (size_t)l * D * D, D, 32 * nb, 64 * kb, 32 * nb, scr, lane); return; }
    r -= CONV_OUT;
    { const int mat = r / 32, q = r % 32, kb = q / 8, nb = q % 8, n0 = 32 * nb;
      const int h = mat & 3, d = (mat >> 2) & 1, g = (mat >> 3) & 1;
      const float* src = (g ? a.in[I_WX] : a.in[I_WA]) + (size_t)((l * 2 + d) * 4 + h) * 65536;
      transpose_item(src, 256, (bf16*)(a.ws + WS_WLRU) + (size_t)l * 4096 * 256, 256, h * 1024 + (d * 2 + (n0 >> 7)) * 256 + g * 128 + (n0 & 127), 64 * kb, n0, scr, lane); }
}
__device__ __forceinline__ void conv_range(const Args& a, LAS unsigned char* lds, int l, int lo, int hi, int widx, int nw, int wave, int lane) {
    LAS float* scr = (LAS float*)(lds + wave * 8448);
    for (int r = lo + widx; r < hi; r += nw) conv_item(a, l, r, scr, lane);
}
__device__ __forceinline__ void pro_weights(const Args& a, LAS unsigned char* lds, int gw, int ngw, int wave, int lane) {
    LAS float* scr = (LAS float*)(lds + wave * 8448);
    constexpr int REST = CONV_PER_LAYER - CONV_TAIL_END, NITEMS = CONV_PER_LAYER + (DEPTH - 1) * REST;
    for (int it = gw; it < NITEMS; it += ngw) {
        if (it < CONV_PER_LAYER) conv_item(a, 0, it, scr, lane);
        else { const int q = it - CONV_PER_LAYER; conv_item(a, 1 + q / REST, CONV_TAIL_END + q % REST, scr, lane); }
    }
}

__device__ __forceinline__ void pro_mods(const Args& a, LAS unsigned char* lds, int bid, int nb, int tid) {
    LAS float* sl = (LAS float*)lds; LAS float* sc = sl + D; LAS float* red = sc + D;
    for (int i = tid; i < D; i += 512) { sl[i] = silu_f(a.in[I_C][i]); sc[i] = silu_f(a.in[I_CCTX][i]); }
    __syncthreads();
    const int cq = tid & 15, ks = tid >> 4;
    for (int it = bid; it < DEPTH * (NMODC / 64); it += nb) {
        const int l = it / (NMODC / 64), c0 = (it % (NMODC / 64)) * 64;
        const float* wp = a.in[I_ADAW] + ((size_t)l * D + ks * 64) * NMODC + c0 + 4 * cq;
        f32x4 al = {0.f, 0.f, 0.f, 0.f}, ac = {0.f, 0.f, 0.f, 0.f};
#pragma unroll 8
        for (int kk = 0; kk < 64; ++kk) { const f32x4 w = *(const f32x4*)(wp + (size_t)kk * NMODC); const float s1 = sl[ks * 64 + kk], s2 = sc[ks * 64 + kk]; al += w * s1; ac += w * s2; }
#pragma unroll
        for (int j = 0; j < 4; ++j) { red[(ks * 2 + 0) * 64 + cq * 4 + j] = al[j]; red[(ks * 2 + 1) * 64 + cq * 4 + j] = ac[j]; }
        __syncthreads();
        if (tid < 128) { const int which = tid >> 6, col = tid & 63; float s = a.in[I_ADAB][(size_t)l * NMODC + c0 + col];
            for (int k = 0; k < 32; ++k) s += red[(k * 2 + which) * 64 + col];
            ((float*)(a.ws + WS_MODS))[((size_t)l * 2 + which) * NMODC + c0 + col] = s; }
        __syncthreads();
    }
}

typedef float f32x16 __attribute__((ext_vector_type(16)));
__device__ __forceinline__ int accrow(int r, int h) { return (r & 3) + 8 * (r >> 2) + 4 * h; }
__device__ __forceinline__ float bf_hi(float x) { return __builtin_bit_cast(float, f2bf(x) << 16); }
__device__ __forceinline__ void pro_w4p(const Args& a, int gtid, int nthr) {
    for (int e = gtid; e < DEPTH * 64 * 4 * 64; e += nthr) {
        const int lane = e & 63, s_ = (e >> 6) & 3, cb = (e >> 8) & 63, l = e >> 14, i = lane & 31, h = lane >> 5;
        const float* w4 = a.in[I_FW4] + (size_t)l * 64 * 2048 + 32 * cb + i;
        unsigned hi[4], lo[4];
#pragma unroll
        for (int jj = 0; jj < 4; ++jj) { float v[2], vh[2], vl[2];
#pragma unroll
            for (int q = 0; q < 2; ++q) { const int j = 2 * jj + q, f = 32 * (s_ >> 1) + 16 * (s_ & 1) + 8 * (j >> 2) + 4 * h + (j & 3); v[q] = w4[(size_t)f * 2048]; vh[q] = bf_hi(v[q]); vl[q] = v[q] - vh[q]; }
            hi[jj] = f2bf(vh[0]) | (f2bf(vh[1]) << 16); lo[jj] = f2bf(vl[0]) | (f2bf(vl[1]) << 16); }
        v4u* dst = (v4u*)(a.ws + WS_W4P) + ((size_t)((l * 64 + cb) * 4 + s_) * 2) * 64 + lane;
        dst[0] = (v4u){hi[0], hi[1], hi[2], hi[3]}; dst[64] = (v4u){lo[0], lo[1], lo[2], lo[3]};
    }
}
__device__ __forceinline__ void pro_mods_wave(const Args& a, const LAS float* sl, const LAS float* sc, int widx, int nw, int lane) {
    const int cq = lane & 7, kp = lane >> 3;
    for (int it = widx; it < DEPTH * (NMODC / 32); it += nw) {
        const int l = it / (NMODC / 32), c0 = (it % (NMODC / 32)) * 32 + 4 * cq;
        const float* wp = a.in[I_ADAW] + ((size_t)l * D + kp) * NMODC + c0;
        f32x4 al = {0.f, 0.f, 0.f, 0.f}, ac = {0.f, 0.f, 0.f, 0.f};
#pragma unroll 16
        for (int kk = 0; kk < D / 8; ++kk) { const f32x4 w = *(const f32x4*)(wp + (size_t)kk * 8 * NMODC); const float s1 = sl[kp + 8 * kk], s2 = sc[kp + 8 * kk]; al += w * s1; ac += w * s2; }
#pragma unroll
        for (int j = 0; j < 4; ++j) {
#pragma unroll
            for (int o = 8; o < 64; o <<= 1) { al[j] += __shfl_xor(al[j], o); ac[j] += __shfl_xor(ac[j], o); } }
        if (lane < 8) { const f32x4 bb = *(const f32x4*)(a.in[I_ADAB] + (size_t)l * NMODC + c0);
            *(f32x4*)((float*)(a.ws + WS_MODS) + ((size_t)l * 2 + 0) * NMODC + c0) = al + bb; *(f32x4*)((float*)(a.ws + WS_MODS) + ((size_t)l * 2 + 1) * NMODC + c0) = ac + bb; }
    }
}
__device__ __forceinline__ void pro_filters(const Args& a, int bid, int nb, int wave, int lane, bool do_norm) {
    const int i = lane & 31, h = lane >> 5;
    for (int it = wave < 4 ? bid * 4 + wave : 4 * nb + (wave - 4) * nb + bid; it < DEPTH * 264; it += 8 * nb) {
        const int l = it / 264, q = it % 264, Lsel = q >= 256 ? 1 : 0, tile = Lsel ? q - 256 : q;
        const int L = Lsel ? CTX : SEQ, t = tile * 32 + i;
        const float tt = (float)t / (float)(L - 1), wv = 6.283185307179586f * (float)t / (float)L;
        const float* w1 = a.in[I_FW1] + l * 33 * 64; const float* b1 = a.in[I_FB1] + l * 64;
        const float* w2 = a.in[I_FW2] + l * 64 * 64; const float* b2 = a.in[I_FB2] + l * 64;
        const float* w3 = a.in[I_FW3] + l * 64 * 64; const float* b3 = a.in[I_FB3] + l * 64;
        const float* b4 = a.in[I_FB4] + l * 2048; const float* fr = a.in[I_FREQ] + l * 64;
        f32x16 c0, c1, d0, d1;
#pragma unroll
        for (int r = 0; r < 16; ++r) { c0[r] = b1[accrow(r, h)]; c1[r] = b1[32 + accrow(r, h)]; }
        float w1a[17], w1b[17];
        { int i1 = i; asm volatile("" : "+v"(i1));
#pragma unroll
          for (int s_ = 0; s_ < 17; ++s_) { const int k = 2 * s_ + h; w1a[s_] = k < 33 ? w1[k * 64 + i1] : 0.f; w1b[s_] = k < 33 ? w1[k * 64 + 32 + i1] : 0.f; } }
        __builtin_amdgcn_sched_barrier(0);
#pragma unroll
        for (int s_ = 0; s_ < 17; ++s_) {
            const int k = 2 * s_ + h; float z;
            if (s_ == 0) { z = h ? __cosf(wv * 1e-4f) : tt; }
            else { const int b = (k - 1) & 15; const float f = 1e-4f + (float)b * ((15.0f - 1e-4f) / 15.0f); z = (k <= 16) ? __cosf(wv * f) : -__sinf(wv * f); if (k > 32) z = 0.f; }
            c0 = __builtin_amdgcn_mfma_f32_32x32x2f32(w1a[s_], z, c0, 0, 0, 0); c1 = __builtin_amdgcn_mfma_f32_32x32x2f32(w1b[s_], z, c1, 0, 0, 0);
        }
#pragma unroll
        for (int r = 0; r < 16; ++r) { const int j = accrow(r, h); c0[r] = __sinf(fr[j] * c0[r]); c1[r] = __sinf(fr[32 + j] * c1[r]); }
#pragma unroll 1
        for (int layer = 0; layer < 2; ++layer) {
            const float* w = layer ? w3 : w2; const float* b = layer ? b3 : b2;
            int ii = i; asm volatile("" : "+v"(ii));
#pragma unroll
            for (int r = 0; r < 16; ++r) { d0[r] = b[accrow(r, h)]; d1[r] = b[32 + accrow(r, h)]; }
#pragma unroll
            for (int q4 = 0; q4 < 4; ++q4) {
                float wa[8], wb[8];
#pragma unroll
                for (int r = 0; r < 8; ++r) { const int kk = 32 * (q4 >> 1) + accrow(8 * (q4 & 1) + r, h); wa[r] = w[kk * 64 + ii]; wb[r] = w[kk * 64 + 32 + ii]; }
                __builtin_amdgcn_sched_barrier(0);
#pragma unroll
                for (int r = 0; r < 8; ++r) { const float cv = (q4 >> 1) ? c1[8 * (q4 & 1) + r] : c0[8 * (q4 & 1) + r]; d0 = __builtin_amdgcn_mfma_f32_32x32x2f32(wa[r], cv, d0, 0, 0, 0); d1 = __builtin_amdgcn_mfma_f32_32x32x2f32(wb[r], cv, d1, 0, 0, 0); }
                __builtin_amdgcn_sched_barrier(0);
            }
#pragma unroll
            for (int r = 0; r < 16; ++r) { const int j = accrow(r, h); c0[r] = __sinf(fr[j] * d0[r]); c1[r] = __sinf(fr[32 + j] * d1[r]); }
        }
        bf16x8 Bh[4], Bl[4];
#pragma unroll
        for (int s_ = 0; s_ < 4; ++s_) {
            unsigned wh[4], wl[4];
#pragma unroll
            for (int jj = 0; jj < 4; ++jj) { float v[2], vh[2];
#pragma unroll
                for (int q2 = 0; q2 < 2; ++q2) { const int r = 8 * (s_ & 1) + 2 * jj + q2; v[q2] = (s_ >> 1) ? c1[r] : c0[r]; vh[q2] = bf_hi(v[q2]); }
                wh[jj] = f2bf(vh[0]) | (f2bf(vh[1]) << 16); wl[jj] = f2bf(v[0] - vh[0]) | (f2bf(v[1] - vh[1]) << 16); }
            Bh[s_] = __builtin_bit_cast(bf16x8, (v4u){wh[0], wh[1], wh[2], wh[3]}); Bl[s_] = __builtin_bit_cast(bf16x8, (v4u){wl[0], wl[1], wl[2], wl[3]});
        }
        float* kT = Lsel ? (float*)(a.ws + WS_KTC) + (size_t)l * 2048 * CTX : (float*)(a.ws + WS_KT8) + (size_t)l * 2048 * SEQ;
        float* nrm = (float*)(a.ws + WS_NORM) + (size_t)(l * 2 + Lsel) * 2048;
        const v4u* w4p = (const v4u*)(a.ws + WS_W4P) + (size_t)l * 64 * 4 * 2 * 64 + lane;
#pragma unroll 1
        for (int cb_ = 0; cb_ < 64; ++cb_) {
            const int cb = (cb_ + bid * 5) & 63;
            bf16x8 Ah[4], Al[4];
#pragma unroll
            for (int s_ = 0; s_ < 4; ++s_) { Ah[s_] = __builtin_bit_cast(bf16x8, w4p[(size_t)((cb * 4 + s_) * 2) * 64]); Al[s_] = __builtin_bit_cast(bf16x8, w4p[(size_t)((cb * 4 + s_) * 2 + 1) * 64]); }
            f32x16 acc;
#pragma unroll
            for (int r = 0; r < 16; ++r) acc[r] = b4[32 * cb + accrow(r, h)];
#pragma unroll
            for (int s_ = 0; s_ < 4; ++s_) {
                acc = __builtin_amdgcn_mfma_f32_32x32x16_bf16(Al[s_], Bh[s_], acc, 0, 0, 0);
                acc = __builtin_amdgcn_mfma_f32_32x32x16_bf16(Ah[s_], Bl[s_], acc, 0, 0, 0);
                acc = __builtin_amdgcn_mfma_f32_32x32x16_bf16(Ah[s_], Bh[s_], acc, 0, 0, 0);
            }
            const bool bwd = cb >= 32;
            float sv[16];
#pragma unroll
            for (int r = 0; r < 16; ++r) {
                const int col = 32 * cb + accrow(r, h), ch = col & 1023;
                const float delta = fabsf(-3.0701134573253944f + (float)ch * ((-15.350567286626972f + 3.0701134573253944f) / 1023.0f));
                const float kv = acc[r] * __expf(-tt * delta);
                kT[(size_t)col * L + t] = kv;
                sv[r] = (bwd && t == 0) ? 0.f : fabsf(kv);
            }
#pragma unroll
            for (int k = 0; k < 8; ++k) { const bool bit = (i >> 4) & 1; const float keep = bit ? sv[k + 8] : sv[k], send = bit ? sv[k] : sv[k + 8]; sv[k] = keep + __shfl_xor(send, 16); }
#pragma unroll
            for (int k = 0; k < 4; ++k) { const bool bit = (i >> 3) & 1; const float keep = bit ? sv[k + 4] : sv[k], send = bit ? sv[k] : sv[k + 4]; sv[k] = keep + __shfl_xor(send, 8); }
#pragma unroll
            for (int k = 0; k < 2; ++k) { const bool bit = (i >> 2) & 1; const float keep = bit ? sv[k + 2] : sv[k], send = bit ? sv[k] : sv[k + 2]; sv[k] = keep + __shfl_xor(send, 4); }
            { const bool bit = (i >> 1) & 1; const float keep = bit ? sv[1] : sv[0], send = bit ? sv[0] : sv[1]; sv[0] = keep + __shfl_xor(send, 2); }
            sv[0] += __shfl_xor(sv[0], 1);
            if (do_norm && (i & 1) == 0) unsafeAtomicAdd(nrm + 32 * cb + accrow((i >> 1) & 15, h), sv[0]);
        }
    }
}

constexpr int FFT_LDS_BYTES = (FFTN + FFTN / 16) * 8, FFT_TW_OFF = FFT_LDS_BYTES;
static_assert(FFT_TW_OFF + 192 * 8 <= LDS_CTLW, "FFT LDS map");
#define FA(i) ((i) + (((i) >> 6) << 2))
__device__ __forceinline__ void fft_tables(LAS f32x2* twh, LAS f32x2* twl, int tid) {
    if (tid < 64) { float s, c; sincospif(2.0f * (float)(tid * 128) / (float)FFTN, &s, &c); twh[tid] = (f32x2){c, -s}; }
    else if (tid < 192) { const int j = tid - 64; float s, c; sincospif(2.0f * (float)j / (float)FFTN, &s, &c); twl[j] = (f32x2){c, -s}; }
}
__device__ __forceinline__ f32x2 cmul(f32x2 a, f32x2 b) { return (f32x2){a.x * b.x - a.y * b.y, a.x * b.y + a.y * b.x}; }
__device__ __forceinline__ f32x2 cmulc(f32x2 a, f32x2 b) { return (f32x2){a.x * b.x + a.y * b.y, a.y * b.x - a.x * b.y}; }
__device__ __forceinline__ f32x2 twid(const LAS f32x2* twh, const LAS f32x2* twl, int j) { return cmul(twh[j >> 7], twl[j & 127]); }
__device__ __forceinline__ int brev14(int f) { return (int)(__brev((unsigned)f) >> 18); }
#define C16_C 0.92387953251128674f
#define C16_S 0.38268343236508977f
#define RH 0.70710678118654752f
__device__ __forceinline__ f32x2 c16(int jj) { switch (jj) { case 0: return (f32x2){1.f, 0.f}; case 1: return (f32x2){C16_C, -C16_S}; case 2: return (f32x2){RH, -RH}; case 3: return (f32x2){C16_S, -C16_C};
    case 4: return (f32x2){0.f, -1.f}; case 5: return (f32x2){-C16_S, -C16_C}; case 6: return (f32x2){-RH, -RH}; default: return (f32x2){-C16_C, -C16_S}; } }
__device__ __forceinline__ void r16_fwd(f32x2 (&v)[16], f32x2 t1) {
    const f32x2 t2 = cmul(t1, t1), t4 = cmul(t2, t2), t8 = cmul(t4, t4);
#pragma unroll
    for (int jj = 0; jj < 8; ++jj) { const f32x2 w = cmul(t1, c16(jj)); const f32x2 a = v[jj], c = v[jj + 8]; v[jj] = a + c; v[jj + 8] = cmul(a - c, w); }
#pragma unroll
    for (int jj = 0; jj < 4; ++jj) { const f32x2 w = cmul(t2, c16(2 * jj));
#pragma unroll
        for (int b = 0; b < 16; b += 8) { const f32x2 a = v[b + jj], c = v[b + jj + 4]; v[b + jj] = a + c; v[b + jj + 4] = cmul(a - c, w); } }
#pragma unroll
    for (int jj = 0; jj < 2; ++jj) { const f32x2 w = cmul(t4, c16(4 * jj));
#pragma unroll
        for (int b = 0; b < 16; b += 4) { const f32x2 a = v[b + jj], c = v[b + jj + 2]; v[b + jj] = a + c; v[b + jj + 2] = cmul(a - c, w); } }
#pragma unroll
    for (int b = 0; b < 16; b += 2) { const f32x2 a = v[b], c = v[b + 1]; v[b] = a + c; v[b + 1] = cmul(a - c, t8); }
}
__device__ __forceinline__ void r16_inv(f32x2 (&v)[16], f32x2 t1) {
    const f32x2 t2 = cmul(t1, t1), t4 = cmul(t2, t2), t8 = cmul(t4, t4);
#pragma unroll
    for (int b = 0; b < 16; b += 2) { const f32x2 a = v[b], c = cmulc(v[b + 1], t8); v[b] = a + c; v[b + 1] = a - c; }
#pragma unroll
    for (int jj = 0; jj < 2; ++jj) { const f32x2 w = cmul(t4, c16(4 * jj));
#pragma unroll
        for (int b = 0; b < 16; b += 4) { const f32x2 a = v[b + jj], c = cmulc(v[b + jj + 2], w); v[b + jj] = a + c; v[b + jj + 2] = a - c; } }
#pragma unroll
    for (int jj = 0; jj < 4; ++jj) { const f32x2 w = cmul(t2, c16(2 * jj));
#pragma unroll
        for (int b = 0; b < 16; b += 8) { const f32x2 a = v[b + jj], c = cmulc(v[b + jj + 4], w); v[b + jj] = a + c; v[b + jj + 4] = a - c; } }
#pragma unroll
    for (int jj = 0; jj < 8; ++jj) { const f32x2 w = cmul(t1, c16(jj)); const f32x2 a = v[jj], c = cmulc(v[jj + 8], w); v[jj] = a + c; v[jj + 8] = a - c; }
}
__device__ __forceinline__ void fft_store_p1(LAS f32x2* x, const f32x2 (&v)[16], int b) {
#pragma unroll
    for (int j = 0; j < 16; ++j) x[FA(b + 1024 * j)] = v[j];
}
__device__ __forceinline__ void fft_fwd_tail(LAS f32x2* x, const LAS f32x2* twh, const LAS f32x2* twl, int tid) {
    __syncthreads();
#pragma unroll
    for (int g = tid; g < 1024; g += 512) { const int hi = g >> 6, lo = g & 63, base = hi * 1024 + lo; f32x2 v[16];
#pragma unroll
        for (int j = 0; j < 16; ++j) v[j] = x[FA(base + 64 * j)];
        r16_fwd(v, twid(twh, twl, lo * 16));
#pragma unroll
        for (int j = 0; j < 16; ++j) x[FA(base + 64 * j)] = v[j]; }
    __syncthreads();
#pragma unroll
    for (int g = tid; g < 1024; g += 512) { const int hi = g >> 2, lo = g & 3, base = hi * 64 + lo; f32x2 v[16];
#pragma unroll
        for (int j = 0; j < 16; ++j) v[j] = x[FA(base + 4 * j)];
        r16_fwd(v, twid(twh, twl, lo * 256));
#pragma unroll
        for (int j = 0; j < 16; ++j) x[FA(base + 4 * j)] = v[j]; }
    __syncthreads();
#pragma unroll 2
    for (int g = tid; g < 4096; g += 512) { LAS f32x4* p = (LAS f32x4*)(x + FA(4 * g)); const f32x4 u0 = p[0], u1 = p[1];
        f32x2 v0 = {u0.x, u0.y}, v1 = {u0.z, u0.w}, v2 = {u1.x, u1.y}, v3 = {u1.z, u1.w};
        const f32x2 a0 = v0 + v2, a2 = v0 - v2, a1 = v1 + v3, d = v1 - v3, a3 = (f32x2){d.y, -d.x};
        v0 = a0 + a1; v1 = a0 - a1; v2 = a2 + a3; v3 = a2 - a3;
        p[0] = (f32x4){v0.x, v0.y, v1.x, v1.y}; p[1] = (f32x4){v2.x, v2.y, v3.x, v3.y}; }
    __syncthreads();
}
__device__ __forceinline__ void fft_inv_head(LAS f32x2* x, const LAS f32x2* twh, const LAS f32x2* twl, int tid) {
#pragma unroll 2
    for (int g = tid; g < 4096; g += 512) { LAS f32x4* p = (LAS f32x4*)(x + FA(4 * g)); const f32x4 u0 = p[0], u1 = p[1];
        f32x2 v0 = {u0.x, u0.y}, v1 = {u0.z, u0.w}, v2 = {u1.x, u1.y}, v3 = {u1.z, u1.w};
        const f32x2 a0 = v0 + v1, a1 = v0 - v1, a2 = v2 + v3, d = v2 - v3, a3 = (f32x2){-d.y, d.x};
        v0 = a0 + a2; v2 = a0 - a2; v1 = a1 + a3; v3 = a1 - a3;
        p[0] = (f32x4){v0.x, v0.y, v1.x, v1.y}; p[1] = (f32x4){v2.x, v2.y, v3.x, v3.y}; }
    __syncthreads();
#pragma unroll
    for (int g = tid; g < 1024; g += 512) { const int hi = g >> 2, lo = g & 3, base = hi * 64 + lo; f32x2 v[16];
#pragma unroll
        for (int j = 0; j < 16; ++j) v[j] = x[FA(base + 4 * j)];
        r16_inv(v, twid(twh, twl, lo * 256));
#pragma unroll
        for (int j = 0; j < 16; ++j) x[FA(base + 4 * j)] = v[j]; }
    __syncthreads();
#pragma unroll
    for (int g = tid; g < 1024; g += 512) { const int hi = g >> 6, lo = g & 63, base = hi * 1024 + lo; f32x2 v[16];
#pragma unroll
        for (int j = 0; j < 16; ++j) v[j] = x[FA(base + 64 * j)];
        r16_inv(v, twid(twh, twl, lo * 16));
#pragma unroll
        for (int j = 0; j < 16; ++j) x[FA(base + 64 * j)] = v[j]; }
    __syncthreads();
}

__device__ __forceinline__ void pro_fftk(const Args& a, LAS unsigned char* lds, int bid, int nb, int tid) {
    LAS f32x2* x = (LAS f32x2*)lds; LAS f32x2* twh = (LAS f32x2*)(lds + FFT_TW_OFF); LAS f32x2* twl = twh + 64;
    fft_tables(twh, twl, tid);
    __syncthreads();
    for (int it = bid; it < DEPTH * 512; it += nb) {
        const int l = it >> 9, p = it & 511, c1 = 2 * p, c2 = c1 + 1;
        const float* kT = (const float*)(a.ws + WS_KT8) + (size_t)l * 2048 * SEQ;
        const float* nrm = (const float*)(a.ws + WS_NORM) + (size_t)(l * 2) * 2048;
        const float i1 = 1.0f / (nrm[c1] + nrm[1024 + c1]), i2 = 1.0f / (nrm[c2] + nrm[1024 + c2]);
#pragma unroll
        for (int b = tid; b < 1024; b += 512) { f32x2 v[16];
#pragma unroll
            for (int j = 0; j < 8; ++j) v[j] = (f32x2){kT[(size_t)c1 * SEQ + b + 1024 * j] * i1, kT[(size_t)c2 * SEQ + b + 1024 * j] * i2};
#pragma unroll
            for (int j = 8; j < 16; ++j) { const int idx = b + 1024 * j;
                v[j] = idx == SEQ ? (f32x2){0.f, 0.f} : (f32x2){kT[(size_t)(1024 + c1) * SEQ + (FFTN - idx)] * i1, kT[(size_t)(1024 + c2) * SEQ + (FFTN - idx)] * i2}; }
            r16_fwd(v, twid(twh, twl, b));
            fft_store_p1(x, v, b); }
        fft_fwd_tail(x, twh, twl, tid);
        v2u* spec = (v2u*)(a.ws + WS_SPEC) + ((size_t)l * 512 + p) * SPEC_PITCH;
        const float sc = 0.5f;
        for (int pe = tid; pe <= FFTN / 2; pe += 512) {
            const int pp = pe < FFTN / 2 ? 2 * pe : 1, f = brev14(pp), qq = brev14((FFTN - f) & (FFTN - 1));
            const f32x2 zf = x[FA(pp)], zn = x[FA(qq)];
            const f32x2 k1 = (f32x2){0.5f * (zf.x + zn.x), 0.5f * (zf.y - zn.y)};
            const f32x2 dd = (f32x2){zf.x - zn.x, zf.y + zn.y};
            const f32x2 k2 = (f32x2){0.5f * dd.y, -0.5f * dd.x};
            spec[pe] = (v2u){pack_h2((k1.x + k2.x) * sc, (k1.y + k2.y) * sc), pack_h2((k1.x - k2.x) * sc, (k1.y - k2.y) * sc)};
        }
        __syncthreads();
    }
}

__device__ __forceinline__ void ph_norm(const Args& a, int l, int s, int nslab, int gw, int ngw, int lane) {
    xh* X = (xh*)(a.ws + WS_X); bf16* U = (bf16*)(a.ws + WS_U);
    const bool in_l = (l == 0 && s == 0), in_c = (l == 0 && s <= 1);
    const float* g = a.in[I_NORMG] + ((size_t)l * 3 + s) * D;
    const bool permute = (s == 1) && (l & 1);
    const int nbk = ngw >> 3, bidk = gw >> 3, wv = gw & 7;
    const bool ctxw = wv == 0;
    if (!ctxw && !in_l) {
        const float* mod = (const float*)(a.ws + WS_MODS) + (size_t)l * 2 * NMODC + (size_t)(3 * s) * D;
        f32x4 ga[4][2], sh[4][2];
#pragma unroll
        for (int j = 0; j < 4; ++j)
#pragma unroll
            for (int h = 0; h < 2; ++h) { const int c = 8 * lane + 512 * j + 4 * h; ga[j][h] = *(const f32x4*)(g + c) * (*(const f32x4*)(mod + D + c) + 1.0f); sh[j][h] = *(const f32x4*)(mod + c); }
        const int step = nbk * 7; int r = bidk * 7 + (wv - 1);
        h8 cur[4];
        if (r < SEQ) { const int src = permute ? (r & (GRID_R - 1)) * GRID_W + (r >> 7) : r; const h8* xr = (const h8*)(X + (size_t)src * D) + lane;
#pragma unroll
            for (int j = 0; j < 4; ++j) cur[j] = xr[64 * j]; }
        while (r < SEQ) {
            const int rn = r + step, rq = rn < SEQ ? rn : r; h8 nxt[4];
            { const int src = permute ? (rq & (GRID_R - 1)) * GRID_W + (rq >> 7) : rq; const h8* xr = (const h8*)(X + (size_t)src * D) + lane;
#pragma unroll
              for (int j = 0; j < 4; ++j) nxt[j] = xr[64 * j]; }
            f32x4 v[4][2]; float ss = 0.f;
#pragma unroll
            for (int j = 0; j < 4; ++j) { v[j][0] = __builtin_convertvector(__builtin_shufflevector(cur[j], cur[j], 0, 1, 2, 3), f32x4); v[j][1] = __builtin_convertvector(__builtin_shufflevector(cur[j], cur[j], 4, 5, 6, 7), f32x4);
#pragma unroll
                for (int h = 0; h < 2; ++h) ss += (v[j][h].x * v[j][h].x + v[j][h].y * v[j][h].y) + (v[j][h].z * v[j][h].z + v[j][h].w * v[j][h].w); }
            const float rs = rsqrtf(wave_sum(ss) * (1.0f / D) + EPS);
            bf16* o = U + (size_t)r * D + 8 * lane;
#pragma unroll
            for (int j = 0; j < 4; ++j) { const f32x4 y0 = v[j][0] * rs * ga[j][0] + sh[j][0], y1 = v[j][1] * rs * ga[j][1] + sh[j][1];
                st16_wt(o + 512 * j, (v4u){pk2(y0.x, y0.y), pk2(y0.z, y0.w), pk2(y1.x, y1.y), pk2(y1.z, y1.w)}); }
#pragma unroll
            for (int j = 0; j < 4; ++j) cur[j] = nxt[j];
            r = rn;
        }
        return;
    }
    for (int r = ctxw ? SEQ + bidk : bidk * 7 + (wv - 1); r < (ctxw ? MROWS : SEQ); r += ctxw ? nbk : nbk * 7) {
        const int which = r >= SEQ ? 1 : 0;
        const float* mod = (const float*)(a.ws + WS_MODS) + ((size_t)l * 2 + which) * NMODC + (size_t)(3 * s) * D;
        int src = r; if (permute && r < SEQ) src = (r & (GRID_R - 1)) * GRID_W + (r >> 7);
        f32x4 v[8]; float ss = 0.f;
        if (which ? in_c : in_l) { const f32x4* xr = (const f32x4*)((which ? a.in[I_CTX] - (size_t)SEQ * D : a.in[I_X]) + (size_t)src * D) + lane;
#pragma unroll
            for (int j = 0; j < 8; ++j) v[j] = xr[64 * j];
            if (!which) { h4* xw = (h4*)(X + (size_t)r * D) + lane;
#pragma unroll
                for (int j = 0; j < 8; ++j) xw[64 * j] = __builtin_convertvector(v[j], h4); }
        } else { const h4* xr = (const h4*)(X + (size_t)src * D) + lane; h4 t[8];
#pragma unroll
            for (int j = 0; j < 8; ++j) t[j] = xr[64 * j];
#pragma unroll
            for (int j = 0; j < 8; ++j) v[j] = __builtin_convertvector(t[j], f32x4); }
        if (which && nslab) {
            for (int k0 = 0; k0 < nslab; k0 += 6) { h4 sv[6][8];
#pragma unroll
                for (int kk = 0; kk < 6; ++kk) { const int k = k0 + kk < nslab ? k0 + kk : nslab - 1; const h4* sr = (const h4*)((const xh*)(a.ws + WS_SLAB) + ((size_t)k * CTX + (r - SEQ)) * D) + lane;
#pragma unroll
                    for (int j = 0; j < 8; ++j) sv[kk][j] = sr[64 * j]; }
#pragma unroll
                for (int kk = 0; kk < 6; ++kk) if (k0 + kk < nslab) {
#pragma unroll
                    for (int j = 0; j < 8; ++j) v[j] += __builtin_convertvector(sv[kk][j], f32x4); } }
            h4* xw = (h4*)(X + (size_t)r * D) + lane;
#pragma unroll
            for (int j = 0; j < 8; ++j) xw[64 * j] = __builtin_convertvector(v[j], h4);
        }
#pragma unroll
        for (int j = 0; j < 8; ++j) ss += (v[j].x * v[j].x + v[j].y * v[j].y) + (v[j].z * v[j].z + v[j].w * v[j].w);
        const float rs = rsqrtf(wave_sum(ss) * (1.0f / D) + EPS);
        v2u* o = (v2u*)(U + (size_t)r * D) + lane;
#pragma unroll
        for (int j = 0; j < 8; ++j) { const int c = 4 * lane + 256 * j; const f32x4 gg = *(const f32x4*)(g + c), sh = *(const f32x4*)(mod + c), scl = *(const f32x4*)(mod + D + c);
            const f32x4 y = v[j] * rs * gg * (scl + 1.0f) + sh;
            v2u w; w.x = pk2(y.x, y.y); w.y = pk2(y.z, y.w); o[64 * j] = w; }
    }
}

__device__ __forceinline__ void ph_convs(const Args& a, int l, LAS unsigned char* lds, int bid, int nb, int tid) {
    const bf16* P = (const bf16*)(a.ws + WS_P);
    LAS float* wt = (LAS float*)lds;
    const int cl = tid & 63, rg = tid >> 6;
    for (int it = bid; it < (SEQ / 64) * 8; it += nb) {
        const int rb = it >> 3, cb = it & 7, r0 = rb * 64, c = cb * 128 + 2 * cl;
        const int lo = rb >= SEQ / 64 ? SEQ : 0, hi = rb >= SEQ / 64 ? MROWS : SEQ;
        const int rs0 = r0 + rg * 8;
        unsigned ux[11], uh[3][10];
#pragma unroll
        for (int i = 0; i < 11; ++i) { const int r = rs0 - 1 + i, rc = r < lo ? lo : (r >= hi ? hi - 1 : r); ux[i] = *(const unsigned*)(P + (size_t)rc * IN_COLS + c); }
#pragma unroll
        for (int g = 0; g < 3; ++g)
#pragma unroll
            for (int i = 0; i < 10; ++i) { const int r = rs0 - 1 + i, rc = r < lo ? lo : (r >= hi ? hi - 1 : r); uh[g][i] = *(const unsigned*)(P + (size_t)rc * IN_COLS + 2048 + g * 1024 + c); }
        { const float* cw = a.in[I_LCW] + (size_t)l * 4 * 1024; const f32x2 w0 = *(const f32x2*)(cw + c), w1 = *(const f32x2*)(cw + 1024 + c), w2 = *(const f32x2*)(cw + 2048 + c), w3 = *(const f32x2*)(cw + 3072 + c), bb = *(const f32x2*)(a.in[I_LCB] + l * 1024 + c);
          f32x2 xv[11];
#pragma unroll
          for (int i = 0; i < 11; ++i) { const int r = rs0 - 1 + i; const unsigned u = (r >= lo && r < hi) ? ux[i] : 0u; xv[i] = (f32x2){bf_lo(u), bf_hi2(u)}; }
#pragma unroll
          for (int i = 0; i < 8; ++i) { const f32x2 cv = bb + w0 * xv[i] + w1 * xv[i + 1] + w2 * xv[i + 2] + w3 * xv[i + 3];
              *(unsigned*)((bf16*)(a.ws + WS_CVB) + (size_t)(rs0 + i) * 1024 + c) = pk2(cv.x, cv.y); } }
        f32x2 z[3][8];
#pragma unroll
        for (int g = 0; g < 3; ++g) { const int col = g * 1024 + c; const float* cw = a.in[I_HCW] + (size_t)l * 3 * 3072; const f32x2 w0 = *(const f32x2*)(cw + col), w1 = *(const f32x2*)(cw + 3072 + col), w2 = *(const f32x2*)(cw + 6144 + col), bb = *(const f32x2*)(a.in[I_HCB] + l * 3072 + col);
            f32x2 xv[10];
#pragma unroll
            for (int i = 0; i < 10; ++i) { const int r = rs0 - 1 + i; const unsigned u = (r >= lo && r < hi) ? uh[g][i] : 0u; xv[i] = (f32x2){bf_lo(u), bf_hi2(u)}; }
#pragma unroll
            for (int i = 0; i < 8; ++i) z[g][i] = bb + w0 * xv[i] + w1 * xv[i + 1] + w2 * xv[i + 2]; }
#pragma unroll
        for (int i = 0; i < 8; ++i) *(unsigned*)((bf16*)(a.ws + WS_X0) + (size_t)(rs0 + i) * 1024 + c) = pk2(z[0][i].x, z[0][i].y);
        {
#pragma unroll
            for (int i = 0; i < 8; ++i) { const f32x2 w = z[2][i] * z[1][i]; wt[(2 * cl) * 65 + rg * 8 + i] = w.x; wt[(2 * cl + 1) * 65 + rg * 8 + i] = w.y; }
            __syncthreads();
            { const int c2 = tid >> 2, seg = tid & 3; const LAS float* sp = wt + c2 * 65 + seg * 16;
              if (rb >= SEQ / 64) { float* dst = (float*)(a.ws + WS_WCTX) + (size_t)(cb * 128 + c2) * CTX + (r0 - SEQ) + seg * 16;
#pragma unroll
                  for (int k = 0; k < 4; ++k) *(f32x4*)(dst + 4 * k) = (f32x4){sp[4 * k], sp[4 * k + 1], sp[4 * k + 2], sp[4 * k + 3]}; }
              else { bf16* dst = (bf16*)(a.ws + WS_WT) + (size_t)(cb * 128 + c2) * SEQ + r0 + seg * 16;
#pragma unroll
                  for (int k = 0; k < 2; ++k) *(v4u*)(dst + 8 * k) = (v4u){pk2(sp[8 * k], sp[8 * k + 1]), pk2(sp[8 * k + 2], sp[8 * k + 3]), pk2(sp[8 * k + 4], sp[8 * k + 5]), pk2(sp[8 * k + 6], sp[8 * k + 7])}; } }
            __syncthreads();
        }
    }
    for (int sub = bid; sub < (CTX / 8) * 8; sub += nb) {
        const int rbs = sub >> 3, cb = sub & 7, c = cb * 128 + 2 * cl, row = SEQ + rbs * 8 + rg;
        unsigned ux[4], uh[3][3];
#pragma unroll
        for (int i = 0; i < 4; ++i) { const int r = row - 1 + i, rc = r < SEQ ? SEQ : (r >= MROWS ? MROWS - 1 : r); ux[i] = *(const unsigned*)(P + (size_t)rc * IN_COLS + c); }
#pragma unroll
        for (int g = 0; g < 3; ++g)
#pragma unroll
            for (int i = 0; i < 3; ++i) { const int r = row - 1 + i, rc = r < SEQ ? SEQ : (r >= MROWS ? MROWS - 1 : r); uh[g][i] = *(const unsigned*)(P + (size_t)rc * IN_COLS + 2048 + g * 1024 + c); }
        { const float* cw = a.in[I_LCW] + (size_t)l * 4 * 1024; f32x2 cv = *(const f32x2*)(a.in[I_LCB] + l * 1024 + c);
#pragma unroll
          for (int i = 0; i < 4; ++i) { const int r = row - 1 + i; const unsigned u = (r >= SEQ && r < MROWS) ? ux[i] : 0u; cv += *(const f32x2*)(cw + i * 1024 + c) * (f32x2){bf_lo(u), bf_hi2(u)}; }
          *(unsigned*)((bf16*)(a.ws + WS_CVB) + (size_t)row * 1024 + c) = pk2(cv.x, cv.y); }
        f32x2 z[3];
#pragma unroll
        for (int g = 0; g < 3; ++g) { const int col = g * 1024 + c; const float* cw = a.in[I_HCW] + (size_t)l * 3 * 3072; z[g] = *(const f32x2*)(a.in[I_HCB] + l * 3072 + col);
#pragma unroll
            for (int i = 0; i < 3; ++i) { const int r = row - 1 + i; const unsigned u = (r >= SEQ && r < MROWS) ? uh[g][i] : 0u; z[g] += *(const f32x2*)(cw + i * 3072 + col) * (f32x2){bf_lo(u), bf_hi2(u)}; } }
        *(unsigned*)((bf16*)(a.ws + WS_X0) + (size_t)row * 1024 + c) = pk2(z[0].x, z[0].y);
        { const f32x2 w = z[2] * z[1]; wt[(2 * cl) * 9 + rg] = w.x; wt[(2 * cl + 1) * 9 + rg] = w.y; }
        __syncthreads();
        if (tid < 256) { const int c2 = tid >> 1, hf = tid & 1; const LAS float* sp = wt + c2 * 9 + 4 * hf;
            *(f32x4*)((float*)(a.ws + WS_WCTX) + (size_t)(cb * 128 + c2) * CTX + rbs * 8 + 4 * hf) = (f32x4){sp[0], sp[1], sp[2], sp[3]}; }
        __syncthreads();
    }
}

__device__ __forceinline__ int scan_row(int d, int q, int i) {
    if (d == 0) return q < 8 ? SEQ + 32 * q + i : 32 * (q - 8) + i;
    return q < 8 ? SEQ + CTX - 1 - (32 * q + i) : SEQ - 1 - (32 * (q - 8) + i);
}
__device__ __forceinline__ void ph_scan1(const Args& a, int bid, int nb, int tid) {
    for (int it = bid; it < 2 * NCHUNK; it += nb) {
        const int q = it % NCHUNK, d = it / NCHUNK, ch = 2 * tid;
        const unsigned* AB = (const unsigned*)(a.ws + WS_ABP) + (size_t)d * MROWS * 1024 + ch;
        v2u w[32];
#pragma unroll
        for (int i = 0; i < 32; ++i) w[i] = *(const v2u*)(AB + (size_t)scan_row(d, q, i) * 1024);
        float l0 = 0.f, l1 = 0.f, s0 = 0.f, s1 = 0.f;
#pragma unroll
        for (int i = 0; i < 32; ++i) { const float la0 = h_lo(w[i].x), la1 = h_lo(w[i].y); l0 += la0; l1 += la1; s0 = lru_step(la0, h_hi(w[i].x), s0); s1 = lru_step(la1, h_hi(w[i].y), s1); }
        *(f32x2*)((float*)(a.ws + WS_SUMA) + ((size_t)d * NCHUNK + q) * 1024 + ch) = (f32x2){__expf(l0), __expf(l1)};
        *(f32x2*)((float*)(a.ws + WS_SUMB) + ((size_t)d * NCHUNK + q) * 1024 + ch) = (f32x2){s0, s1};
    }
}
__device__ __forceinline__ void ph_scan2(const Args& a, LAS unsigned char* lds, int bid, int tid) {
    if (bid >= 32) return;
    const int lane = tid & 63, wave = tid >> 6, gi = bid * 64 + lane, d = gi >> 10, ch = gi & 1023, q0 = 33 * wave;
    const float* SA = (const float*)(a.ws + WS_SUMA) + (size_t)d * NCHUNK * 1024 + ch; const float* SB = (const float*)(a.ws + WS_SUMB) + (size_t)d * NCHUNK * 1024 + ch;
    float* CY = (float*)(a.ws + WS_CARRY) + (size_t)d * NCHUNK * 1024 + ch;
    LAS float* gA = (LAS float*)lds; LAS float* gB = gA + 512;
    float sa[33], sb[33];
#pragma unroll
    for (int k = 0; k < 33; ++k) { sa[k] = SA[(size_t)(q0 + k) * 1024]; sb[k] = SB[(size_t)(q0 + k) * 1024]; }
    float pa = 1.f, pb = 0.f;
#pragma unroll
    for (int k = 0; k < 33; ++k) { pa *= sa[k]; pb = sa[k] * pb + sb[k]; }
    gA[wave * 64 + lane] = pa; gB[wave * 64 + lane] = pb;
    __syncthreads();
    float st = 0.f;
    for (int g = 0; g < wave; ++g) st = gA[g * 64 + lane] * st + gB[g * 64 + lane];
#pragma unroll
    for (int k = 0; k < 33; ++k) { CY[(size_t)(q0 + k) * 1024] = st; st = sa[k] * st + sb[k]; }
}
__device__ __forceinline__ void ph_ctxconv(const Args& a, int l, LAS unsigned char* lds, int first, int bid, int nb, int tid) {
    if (bid < first) return;
    const int lane = tid & 63, wave = tid >> 6;
    LAS float* kk = (LAS float*)lds + wave * 768;
    LAS float* wl = kk + 512;
    const float* KTC = (const float*)(a.ws + WS_KTC) + (size_t)l * 2048 * CTX; const float* nrm = (const float*)(a.ws + WS_NORM) + (size_t)(l * 2 + 1) * 2048;
    for (int c = (bid - first) * 8 + wave; c < 1024; c += (nb - first) * 8) {
        const float inv = 1.0f / (nrm[c] + nrm[1024 + c]);
        float wr[4];
#pragma unroll
        for (int j = 0; j < 4; ++j) { const int t = lane + 64 * j; wr[j] = ((const float*)(a.ws + WS_WCTX))[(size_t)c * CTX + t];
            kk[255 + t] = KTC[(size_t)c * CTX + t] * inv; if (t > 0) kk[255 - t] = KTC[(size_t)(1024 + c) * CTX + t] * inv; wl[t] = wr[j]; }
        LDS_WAIT(); asm volatile("" ::: "memory");
        float acc[4] = {0.f, 0.f, 0.f, 0.f};
#pragma unroll 4
        for (int s4 = 0; s4 < CTX; s4 += 4) { const f32x4 w4 = *(const LAS f32x4*)(wl + s4);
#pragma unroll
            for (int q = 0; q < 4; ++q) { const float wv = w4[q];
#pragma unroll
                for (int j = 0; j < 4; ++j) acc[j] = fmaf(kk[lane + 64 * j - (s4 + q) + 255], wv, acc[j]); } }
        const float hb = a.in[I_HBIAS][l * 1024 + c];
#pragma unroll
        for (int j = 0; j < 4; ++j) ((float*)(a.ws + WS_YCTX))[(size_t)c * CTX + lane + 64 * j] = acc[j] + hb * wr[j];
        LDS_WAIT(); asm volatile("" ::: "memory");
    }
}

__device__ __forceinline__ void ph_fftconv(const Args& a, int l, LAS unsigned char* lds, int bid, int nb, int tid) {
    LAS f32x2* x = (LAS f32x2*)lds; LAS f32x2* twh = (LAS f32x2*)(lds + FFT_TW_OFF); LAS f32x2* twl = twh + 64;
    fft_tables(twh, twl, tid);
    __syncthreads();
    for (int p = bid; p < 512; p += nb) {
        const bf16* w1 = (const bf16*)(a.ws + WS_WT) + (size_t)(2 * p) * SEQ; const bf16* w2 = w1 + SEQ;
        const v2u* spec = (const v2u*)(a.ws + WS_SPEC) + ((size_t)l * 512 + p) * SPEC_PITCH;
        v2u sp[16];
#pragma unroll
        for (int k = 0; k < 16; ++k) sp[k] = spec[tid + 512 * k];
        { unsigned u1[8], u2[8];
#pragma unroll
          for (int j = 0; j < 8; ++j) { u1[j] = *(const unsigned*)(w1 + 2 * tid + 1024 * j); u2[j] = *(const unsigned*)(w2 + 2 * tid + 1024 * j); }
#pragma unroll
          for (int e = 0; e < 2; ++e) { const int b = 2 * tid + e; f32x2 v[16];
#pragma unroll
            for (int j = 0; j < 8; ++j) v[j] = e ? (f32x2){bf_hi2(u1[j]), bf_hi2(u2[j])} : (f32x2){bf_lo(u1[j]), bf_lo(u2[j])};
#pragma unroll
            for (int j = 8; j < 16; ++j) v[j] = (f32x2){0.f, 0.f};
            r16_fwd(v, twid(twh, twl, b));
            fft_store_p1(x, v, b); } }
        fft_fwd_tail(x, twh, twl, tid);
#pragma unroll
        for (int k = 0; k <= 16; ++k) {
            const int pe = tid + 512 * k; if (k == 16 && tid != 0) break;
            const int pp = k < 16 ? 2 * pe : 1, f = brev14(pp), qq = brev14((FFTN - f) & (FFTN - 1));
            const v2u ab = k < 16 ? sp[k < 16 ? k : 0] : spec[FFTN / 2]; const f32x2 A = {h_lo(ab.x), h_hi(ab.x)}, B = {h_lo(ab.y), h_hi(ab.y)};
            const f32x2 zf = x[FA(pp)], zn = x[FA(qq)];
            const f32x2 yp = cmul(A, zf) + cmulc(B, zn);
            if (qq != pp) { const f32x2 cz = (f32x2){zf.x, -zf.y};
                const f32x2 yq = cmulc(zn, A) + (f32x2){B.x * cz.x + B.y * cz.y, B.x * cz.y - B.y * cz.x}; x[FA(qq)] = yq; }
            x[FA(pp)] = yp;
        }
        __syncthreads();
        fft_inv_head(x, twh, twl, tid);
        const float hb1 = a.in[I_HBIAS][l * 1024 + 2 * p], hb2 = a.in[I_HBIAS][l * 1024 + 2 * p + 1];
        bf16* y1 = (bf16*)(a.ws + WS_YT) + (size_t)(2 * p) * SEQ; bf16* y2 = y1 + SEQ;
        { unsigned u1[8], u2[8]; f32x2 yo[2][8];
#pragma unroll
          for (int j = 0; j < 8; ++j) { u1[j] = *(const unsigned*)(w1 + 2 * tid + 1024 * j); u2[j] = *(const unsigned*)(w2 + 2 * tid + 1024 * j); }
#pragma unroll
          for (int e = 0; e < 2; ++e) { const int b = 2 * tid + e; f32x2 v[16];
#pragma unroll
            for (int j = 0; j < 16; ++j) v[j] = x[FA(b + 1024 * j)];
            r16_inv(v, twid(twh, twl, b));
#pragma unroll
            for (int j = 0; j < 8; ++j) yo[e][j] = (f32x2){v[j].x * (1.0f / FFTN) + hb1 * (e ? bf_hi2(u1[j]) : bf_lo(u1[j])), v[j].y * (1.0f / FFTN) + hb2 * (e ? bf_hi2(u2[j]) : bf_lo(u2[j]))}; }
#pragma unroll
          for (int j = 0; j < 8; ++j) { *(unsigned*)(y1 + 2 * tid + 1024 * j) = pk2(yo[0][j].x, yo[1][j].x); *(unsigned*)(y2 + 2 * tid + 1024 * j) = pk2(yo[0][j].y, yo[1][j].y); } }
        __syncthreads();
    }
}

__device__ __forceinline__ void ph_merge(const Args& a, int l, LAS unsigned char* lds, int jlo, int jhi, int jstep, int tid, int part) {
    LAS float* T = (LAS float*)lds;
    const int lane = tid & 63, wave = tid >> 6;
    const bf16* P = (const bf16*)(a.ws + WS_P); bf16* U = (bf16*)(a.ws + WS_U);
    const float* og = a.in[I_OUTG] + (size_t)l * D;
    for (int j = jlo; j < jhi; j += jstep) {
        const bool isctx = j >= SEQ / 32; const int jc = j - SEQ / 32;
        const int r0 = isctx ? SEQ + 32 * jc : 32 * j, qf = isctx ? jc : 8 + j, qb = isctx ? 7 - jc : 8 + (SEQ / 32 - 1) - j;
        v4u yv[16];
        if (part == 0) {
#pragma unroll
            for (int idx = 0; idx < 16; ++idx) yv[idx] = (v4u){0u, 0u, 0u, 0u}; }
        else if (isctx) { const float* YT = (const float*)(a.ws + WS_YCTX) + (r0 - SEQ);
#pragma unroll
            for (int idx = 0; idx < 16; ++idx) { const int v_ = idx * 8 + wave, seg = v_ & 7, c = (v_ >> 3) * 64 + lane; yv[idx] = *(const v4u*)(YT + (size_t)c * CTX + 4 * seg); } }
        else { const bf16* YT = (const bf16*)(a.ws + WS_YT) + r0;
#pragma unroll
            for (int idx = 0; idx < 16; ++idx) { const int v_ = idx * 8 + wave, seg = v_ & 7, c = (v_ >> 3) * 64 + lane; const v2u q = *(const v2u*)(YT + (size_t)c * SEQ + 4 * seg);
                yv[idx] = (v4u){q.x, q.y, 0u, 0u}; } }
        if (part != 1) { const int ch = 2 * tid;
          float sf0, sf1, sb0, sb1;
          if (isctx) { sf0 = sf1 = sb0 = sb1 = 0.f;
              for (int q = 0; q < qf; ++q) { const f32x2 sa = *(const f32x2*)((const float*)(a.ws + WS_SUMA) + (size_t)q * 1024 + ch), sb = *(const f32x2*)((const float*)(a.ws + WS_SUMB) + (size_t)q * 1024 + ch); sf0 = sa.x * sf0 + sb.x; sf1 = sa.y * sf1 + sb.y; }
              for (int q = 0; q < qb; ++q) { const f32x2 sa = *(const f32x2*)((const float*)(a.ws + WS_SUMA) + ((size_t)NCHUNK + q) * 1024 + ch), sb = *(const f32x2*)((const float*)(a.ws + WS_SUMB) + ((size_t)NCHUNK + q) * 1024 + ch); sb0 = sa.x * sb0 + sb.x; sb1 = sa.y * sb1 + sb.y; } }
          else { const f32x2 cf = *(const f32x2*)((const float*)(a.ws + WS_CARRY) + (size_t)qf * 1024 + ch), cb = *(const f32x2*)((const float*)(a.ws + WS_CARRY) + ((size_t)NCHUNK + qb) * 1024 + ch); sf0 = cf.x; sf1 = cf.y; sb0 = cb.x; sb1 = cb.y; }
          const unsigned* ABf = (const unsigned*)(a.ws + WS_ABP) + (size_t)r0 * 1024 + ch; const unsigned* ABb = ABf + (size_t)MROWS * 1024;
#pragma unroll 1
          for (int hf_ = 0; hf_ < 2; ++hf_) { v2u w[16];
#pragma unroll
              for (int i = 0; i < 16; ++i) w[i] = *(const v2u*)(ABf + (size_t)(16 * hf_ + i) * 1024);
#pragma unroll
              for (int i = 0; i < 16; ++i) { sf0 = lru_step(h_lo(w[i].x), h_hi(w[i].x), sf0); sf1 = lru_step(h_lo(w[i].y), h_hi(w[i].y), sf1); *(LAS f32x2*)(T + (16 * hf_ + i) * 1024 + ch) = (f32x2){sf0, sf1}; } }
#pragma unroll 1
          for (int hf_ = 1; hf_ >= 0; --hf_) { v2u w[16]; unsigned yrw[16];
#pragma unroll
              for (int i = 0; i < 16; ++i) { w[i] = *(const v2u*)(ABb + (size_t)(16 * hf_ + i) * 1024); yrw[i] = *(const unsigned*)(P + (size_t)(r0 + 16 * hf_ + i) * IN_COLS + 1024 + ch); }
#pragma unroll
              for (int i = 15; i >= 0; --i) { sb0 = lru_step(h_lo(w[i].x), h_hi(w[i].x), sb0); sb1 = lru_step(h_lo(w[i].y), h_hi(w[i].y), sb1);
                  LAS f32x2* tp = (LAS f32x2*)(T + (16 * hf_ + i) * 1024 + ch); const f32x2 hf = *tp;
                  *tp = (f32x2){(hf.x + sb0) * gelu_tanh_f(bf_lo(yrw[i])), (hf.y + sb1) * gelu_tanh_f(bf_hi2(yrw[i]))}; } }
        }
        __syncthreads();
        if (part != 1) { f32x4 ogv[4];
#pragma unroll
          for (int k = 0; k < 4; ++k) ogv[k] = *(const f32x4*)(og + 4 * lane + 256 * k);
#pragma unroll
          for (int rr = 0; rr < 4; ++rr) { const int i = wave * 4 + rr; f32x4 v[4]; float ss = 0.f;
#pragma unroll
            for (int k = 0; k < 4; ++k) { v[k] = *(const LAS f32x4*)(T + i * 1024 + 4 * lane + 256 * k); ss += (v[k].x * v[k].x + v[k].y * v[k].y) + (v[k].z * v[k].z + v[k].w * v[k].w); }
            const float rs = rsqrtf(wave_sum(ss) * (1.0f / 1024.0f) + EPS);
#pragma unroll
            for (int k = 0; k < 4; ++k) { const int c = 4 * lane + 256 * k; const f32x4 y = v[k] * rs * ogv[k]; v2u w; w.x = pk2(y.x, y.y); w.y = pk2(y.z, y.w);
                *(v2u*)(U + (size_t)(r0 + i) * D + c) = w; } } }
        __syncthreads();
        if (part != 0) {
#pragma unroll
            for (int idx = 0; idx < 16; ++idx) { const int v_ = idx * 8 + wave, seg = v_ & 7, c = (v_ >> 3) * 64 + lane;
                const v4u q = yv[idx];
                const f32x4 y = isctx ? __builtin_bit_cast(f32x4, q) : (f32x4){bf_lo(q.x), bf_hi2(q.x), bf_lo(q.y), bf_hi2(q.y)};
                T[(4 * seg + 0) * 1024 + c] = y.x; T[(4 * seg + 1) * 1024 + c] = y.y; T[(4 * seg + 2) * 1024 + c] = y.z; T[(4 * seg + 3) * 1024 + c] = y.w; }
        }
        __syncthreads();
        if (part != 0) { f32x4 ogv[4]; v2u xw[4][4];
#pragma unroll
          for (int k = 0; k < 4; ++k) ogv[k] = *(const f32x4*)(og + 1024 + 4 * lane + 256 * k);
#pragma unroll
          for (int rr = 0; rr < 4; ++rr)
#pragma unroll
            for (int k = 0; k < 4; ++k) xw[rr][k] = *(const v2u*)((const bf16*)(a.ws + WS_X0) + (size_t)(r0 + wave * 4 + rr) * 1024 + 4 * lane + 256 * k);
#pragma unroll
          for (int rr = 0; rr < 4; ++rr) { const int i = wave * 4 + rr; f32x4 v[4]; float ss = 0.f;
#pragma unroll
            for (int k = 0; k < 4; ++k) { const v2u q = xw[rr][k]; v[k] = *(const LAS f32x4*)(T + i * 1024 + 4 * lane + 256 * k) * (f32x4){bf_lo(q.x), bf_hi2(q.x), bf_lo(q.y), bf_hi2(q.y)}; ss += (v[k].x * v[k].x + v[k].y * v[k].y) + (v[k].z * v[k].z + v[k].w * v[k].w); }
            const float rs = rsqrtf(wave_sum(ss) * (1.0f / 1024.0f) + EPS);
#pragma unroll
            for (int k = 0; k < 4; ++k) { const int c = 4 * lane + 256 * k; const f32x4 y = v[k] * rs * ogv[k]; v2u w; w.x = pk2(y.x, y.y); w.y = pk2(y.z, y.w);
                *(v2u*)(U + (size_t)(r0 + i) * D + 1024 + c) = w; } } }
        __syncthreads();
    }
}

__device__ __forceinline__ void ph_final(const Args& a, int gw, int ngw, int lane) {
    const xh* X = (const xh*)(a.ws + WS_X); const float* g = a.in[I_FINALG];
    for (int r = gw; r < SEQ; r += ngw) {
        const h4* xr = (const h4*)(X + (size_t)r * D) + lane; h4 t[8]; f32x4 v[8]; float ss = 0.f;
#pragma unroll
        for (int j = 0; j < 8; ++j) t[j] = xr[64 * j];
#pragma unroll
        for (int j = 0; j < 8; ++j) { v[j] = __builtin_convertvector(t[j], f32x4); ss += (v[j].x * v[j].x + v[j].y * v[j].y) + (v[j].z * v[j].z + v[j].w * v[j].w); }
        const float rs = rsqrtf(wave_sum(ss) * (1.0f / D) + EPS);
        f32x4* o = (f32x4*)(a.out + (size_t)r * D) + lane;
#pragma unroll
        for (int j = 0; j < 8; ++j) o[64 * j] = v[j] * rs * *(const f32x4*)(g + 4 * lane + 256 * j);
    }
}

__global__ void __launch_bounds__(512, 2) fwd_kernel(Args a) {
    extern __shared__ __attribute__((aligned(16))) unsigned char lds_raw[];
    LAS unsigned char* lds = (LAS unsigned char*)lds_raw;
    const int lo = a.ph_lo, hi = a.ph_hi;
#if MK_ONE_LAUNCH
    if (threadIdx.x < 16) ((LAS unsigned*)(lds + LDS_CTLW))[threadIdx.x] = 0u;
    __syncthreads();
    XcdBarrier bar = xcd_barrier_post((unsigned*)(a.ws + WS_CTL) + 4096, (volatile LAS unsigned*)(lds + LDS_CTLW));
#define GRID_BAR() xcd_barrier(bar)
#else
#define GRID_BAR() do { } while (0)
#endif
#ifndef DBG_ONLY
#define DBG_ONLY (-1)
#endif
#define EN(tag) (DBG_ONLY < 0 || DBG_ONLY == (tag))
#ifndef DBG_REP
#define DBG_REP 0
#endif
#define REP(tag) for (int rep_ = 0; rep_ < (((DBG_REP >> (tag)) & 1) ? 2 : 1); ++rep_)
#define IN(k) (lo <= (k) && (k) < hi)
#define FRESH() int tid = threadIdx.x; asm volatile("" : "+v"(tid)); const int lane = tid & 63, wave = __builtin_amdgcn_readfirstlane(tid >> 6); int bid = blockIdx.x; asm volatile("" : "+s"(bid)); const int nb = gridDim.x, gw = bid * 8 + wave, ngw = nb * 8; (void)lane; (void)gw; (void)ngw; (void)nb
#define SEAM(k) do { if (IN((k) + 1)) GRID_BAR(); } while (0)

    if (IN(PH_PRO0)) {
        FRESH();
        REP(0) if (EN(0)) pro_weights(a, lds, gw, ngw, wave, lane);
        for (int i = bid * 512 + tid; i < DEPTH * 2 * 1024; i += nb * 512) ((float*)(a.ws + WS_SP8))[i] = 8.0f * log1pf(expf(-a.in[I_LAM][i]));
        __syncthreads();
        pro_w4p(a, bid * 512 + tid, nb * 512);
        SEAM(PH_PRO0);
    }
    if (EN(2) && IN(PH_PRO1)) { FRESH();
        { LAS float* sl = (LAS float*)lds; LAS float* sc = sl + D;
          for (int i = tid; i < D; i += 512) { sl[i] = silu_f(a.in[I_C][i]); sc[i] = silu_f(a.in[I_CCTX][i]); }
          __syncthreads();
          if (wave >= 5) pro_mods_wave(a, sl, sc, (wave - 5) * nb + bid, 3 * nb + (nb - 32), lane);
          else if (wave == 4 && bid >= 32) pro_mods_wave(a, sl, sc, 3 * nb + (bid - 32), 3 * nb + (nb - 32), lane); }
        pro_filters(a, bid, nb, wave, lane, true);
        SEAM(PH_PRO1); }
    if (EN(3) && IN(PH_PRO2)) { FRESH(); __syncthreads(); REP(3) pro_fftk(a, lds, bid, nb, tid); SEAM(PH_PRO2); }

    for (int st = 0; st < DEPTH * 3; ++st) {
        int l = st / 3; const int kind = st % 3;
        const int base = PH_LAYER0 + PH_PER_LAYER * l + (kind == 0 ? 0 : kind == 1 ? 3 : 11);
        if (base >= hi || base + 8 <= lo) continue;
        const float* mods_l = (const float*)(a.ws + WS_MODS) + (size_t)l * 2 * NMODC; const float* mods_c = mods_l + NMODC;
        if (EN(4) && IN(base)) { FRESH(); REP(4) ph_norm(a, l, kind, rep_ ? 0 : (kind == 2 ? (l == DEPTH - 1 ? 0 : 8) : (kind == 0 && l == 0 ? 0 : 11)), gw, ngw, lane); SEAM(base); }
        if (kind != 1) {
            const int f = kind >> 1;
            if (EN(5) && IN(base + 1)) { FRESH();
                pg8::Gemm g{(const bf16*)(a.ws + WS_U), (const bf16*)(a.ws + WS_WUP) + (size_t)(l * 2 + f) * 2 * DFF * D, MROWS, 2 * DFF, D, D, D, 1 << 20, 0, 1 << 20, 0};
                pg8::StaticOrder S; S.init(MROWS, 2 * DFF, nb, bid, 1);
                unsigned* cnt = (unsigned*)(a.ws + WS_CTL + 32768) + 64 * (l * 2 + f);
                const bool need_ctx = !(l == DEPTH - 1 && kind == 2);
                EpiSwiGLU E{(bf16*)(a.ws + WS_H), cnt};
                pg8::gemm_phase<EpiSwiGLU>(lds, g, S, E);
                { const int ublk = S.nwg % nb;
                  if (ublk > 0 && bid >= ublk) {
                      if (need_ctx) {
                          if (tid == 0) { XB_SPIN(xb_ld(cnt) < 44u * 8u, (unsigned*)(a.ws + WS_CTL) + 4096); __builtin_amdgcn_fence(__ATOMIC_ACQUIRE, "agent"); asm volatile("s_waitcnt vmcnt(0)" ::: "memory"); }
                          __syncthreads();
                          pg8::Gemm g2{(const bf16*)(a.ws + WS_H) + (size_t)SEQ * DFF, (const bf16*)(a.ws + WS_WDN) + (size_t)(l * 2 + f) * D * DFF, CTX, D * 11, 512, DFF, DFF, 8, 512, 8, 512};
                          pg8::StaticOrder S2; S2.init(CTX, D * 11, nb - ublk, bid - ublk);
                          EpiSlab E2{(xh*)(a.ws + WS_SLAB), mods_c + (size_t)(3 * kind + 2) * D, 0.5f, 8};
                          pg8::gemm_phase<EpiSlab>(lds, g2, S2, E2);
                      }
                      if (l + 1 < DEPTH && bid >= ublk + 4) conv_range(a, lds, l + 1, kind == 0 ? CONV_T0 : CONV_T3, kind == 0 ? CONV_T1 : CONV_T4, (bid - ublk - 4) * 8 + wave, (nb - ublk - 4) * 8, wave, lane); } }
                SEAM(base + 1);
            }
            if (EN(6) && IN(base + 2)) { FRESH();
                { pg8::Gemm g{(const bf16*)(a.ws + WS_H), (const bf16*)(a.ws + WS_WDN) + (size_t)(l * 2 + f) * D * DFF, SEQ, D, DFF, DFF, DFF, 1 << 20, 0, 1 << 20, 0};
                  pg8::StaticOrder S; S.init(SEQ, D, nb, bid);
                  REP(6) { EpiResid E{(xh*)(a.ws + WS_X), mods_l + (size_t)(3 * kind + 2) * D, (((DBG_REP >> 6) & 1) && rep_ == 0) ? 0.0f : 0.5f, 0};
                  pg8::gemm_phase<EpiResid>(lds, g, S, E); } }
                SEAM(base + 2);
            }
        } else {
            if (EN(7) && IN(base + 1)) { FRESH();
                pg8::Gemm g{(const bf16*)(a.ws + WS_U), (const bf16*)(a.ws + WS_WIN) + (size_t)l * IN_COLS * D, MROWS, IN_COLS, D, D, D, 1 << 20, 0, 1 << 20, 0};
                pg8::StaticOrder S; S.init(MROWS, IN_COLS, nb, bid);
                EpiBf16Out E{(bf16*)(a.ws + WS_P), IN_COLS};
                REP(7) pg8::gemm_phase<EpiBf16Out>(lds, g, S, E);
                { const int ublk = S.nwg % nb;
                  if (l + 1 < DEPTH && ublk > 0 && bid >= ublk) conv_range(a, lds, l + 1, CONV_T1, CONV_T2, (bid - ublk) * 8 + wave, (nb - ublk) * 8, wave, lane); }
                SEAM(base + 1);
            }
            if (EN(8) && IN(base + 2)) { FRESH(); REP(8) ph_convs(a, l, lds, bid, nb, tid); SEAM(base + 2); }
            if (EN(9) && IN(base + 3)) { FRESH();
                pg8::Gemm g{(const bf16*)(a.ws + WS_CVB), (const bf16*)(a.ws + WS_WLRU) + (size_t)l * 4096 * 256, MROWS, 4096, 256, 1024, 256, 4, 256, 1 << 20, 0};
                pg8::StaticOrder S; S.init(MROWS, 4096, nb, bid);
                EpiGates E{a.in[I_BA] + (size_t)l * 2048, a.in[I_BX] + (size_t)l * 2048, (const float*)(a.ws + WS_SP8) + (size_t)l * 2048, (const bf16*)(a.ws + WS_CVB), (unsigned*)(a.ws + WS_ABP)};
                REP(9) pg8::gemm_phase<EpiGates>(lds, g, S, E);
                REP(15) ph_ctxconv(a, l, lds, 16, bid, nb, tid);
                SEAM(base + 3);
            }
            if (IN(base + 4)) { FRESH(); if (EN(10)) { REP(10) ph_scan1(a, bid, nb, tid); } __syncthreads(); if (EN(12)) { REP(12) ph_fftconv(a, l, lds, bid, nb, tid); } SEAM(base + 4); }
            if (EN(11) && IN(base + 5)) { FRESH(); REP(11) { ph_scan2(a, lds, bid, tid); if (bid >= 32 && bid < 48) { const int jc = (bid - 32) >> 1; ph_merge(a, l, lds, SEQ / 32 + jc, SEQ / 32 + jc + 1, 1, tid, (bid - 32) & 1); } __syncthreads(); }
                if (l + 1 < DEPTH && bid >= 48) conv_range(a, lds, l + 1, CONV_T2, CONV_T3, (bid - 48) * 8 + wave, (nb - 48) * 8, wave, lane);
                SEAM(base + 5); }
            if (EN(13) && IN(base + 6)) { FRESH(); __syncthreads(); REP(13) ph_merge(a, l, lds, bid, SEQ / 32, nb, tid, 2); SEAM(base + 6); }
            if (EN(14) && IN(base + 7)) { FRESH();
                { pg8::Gemm g{(const bf16*)(a.ws + WS_U), (const bf16*)(a.ws + WS_WOUT) + (size_t)l * D * D, SEQ, D, D, D, D, 1 << 20, 0, 1 << 20, 0};
                  pg8::StaticOrder S; S.init(SEQ, D, nb, bid);
                  REP(14) { EpiResid E{(xh*)(a.ws + WS_X), mods_l + (size_t)5 * D, (((DBG_REP >> 14) & 1) && rep_ == 0) ? 0.0f : 1.0f, l & 1};
                  pg8::gemm_phase<EpiResid>(lds, g, S, E); } }
                {
                  pg8::Gemm g{(const bf16*)(a.ws + WS_U) + (size_t)SEQ * D, (const bf16*)(a.ws + WS_WOUT) + (size_t)l * D * D, CTX, D * 8, 256, D, D, 8, 256, 8, 256};
                  pg8::StaticOrder S; S.init(CTX, D * 8, nb, bid);
                  EpiSlab E{(xh*)(a.ws + WS_SLAB), mods_c + (size_t)5 * D, 1.0f, 8};
                  REP(14) if (l != DEPTH - 1) pg8::gemm_phase<EpiSlab>(lds, g, S, E);
                  if (l + 1 < DEPTH && bid >= 64) conv_range(a, lds, l + 1, CONV_T5, CONV_T6, (bid - 64) * 8 + wave, (nb - 64) * 8, wave, lane); }
                SEAM(base + 7);
            }
        }
    }
    if (EN(15) && IN(PH_FINAL)) { FRESH(); ph_final(a, gw, ngw, lane); }
#undef IN
#undef SEAM
}

extern "C" void kernel_launch(void* const* d_in, const int* in_sizes, int n_in, void* d_out, int out_size, void* d_ws, size_t ws_size, hipStream_t stream) {
    static int grid = 0;
    if (grid == 0) {
        if (n_in != N_IN || out_size != SEQ * D || ws_size < WS_END) { fprintf(stderr, "kernel_launch: unexpected shapes (n_in %d, out %d, ws %zu < %zu); nothing launched\n", n_in, out_size, ws_size, (size_t)WS_END); grid = -1; return; }
        int dev = 0, cus = 0, per_cu = 0;
        if (hipGetDevice(&dev) != hipSuccess || hipDeviceGetAttribute(&cus, hipDeviceAttributeMultiprocessorCount, dev) != hipSuccess) { grid = -1; return; }
        if (hipFuncSetAttribute((const void*)fwd_kernel, hipFuncAttributeMaxDynamicSharedMemorySize, LDS_BYTES) != hipSuccess) { fprintf(stderr, "kernel_launch: hipFuncSetAttribute failed\n"); grid = -1; return; }
        if (hipOccupancyMaxActiveBlocksPerMultiprocessor(&per_cu, (const void*)fwd_kernel, 512, LDS_BYTES) != hipSuccess || per_cu < 1) fprintf(stderr, "kernel_launch: occupancy query says %d blocks per CU\n", per_cu);
        (void)hipGetLastError();
        grid = cus;
    }
    if (grid < 0) return;
    (void)in_sizes;
    Args a{};
    for (int i = 0; i < N_IN; ++i) a.in[i] = (const float*)d_in[i];
    a.out = (float*)d_out; a.ws = (unsigned char*)d_ws;
    (void)hipMemsetAsync((char*)d_ws + WS_CTL, 0, 131072, stream);
#if MK_ONE_LAUNCH
    a.ph_lo = 0; a.ph_hi = N_PHASES;
    hipLaunchKernelGGL(fwd_kernel, dim3(grid), dim3(512), LDS_BYTES, stream, a);
#else
    for (int ph = 0; ph < N_PHASES; ++ph) { a.ph_lo = ph; a.ph_hi = ph + 1; hipLaunchKernelGGL(fwd_kernel, dim3(grid), dim3(512), LDS_BYTES, stream, a); }
#endif
}
```

```cpp
#include <hip/hip_runtime.h>
#include <cstdio>
#include <cstdint>

#ifndef MK_ONE_LAUNCH
#define MK_ONE_LAUNCH 1
#endif

#define GAS __attribute__((address_space(1)))
#define LAS __attribute__((address_space(3)))
typedef unsigned short bf16;
typedef unsigned v4u __attribute__((ext_vector_type(4)));
typedef unsigned v2u __attribute__((ext_vector_type(2)));
typedef float f32x4 __attribute__((ext_vector_type(4)));
typedef float f32x2 __attribute__((ext_vector_type(2)));
typedef short bf16x8 __attribute__((ext_vector_type(8)));
typedef _Float16 xh;
typedef _Float16 h4 __attribute__((ext_vector_type(4)));
typedef _Float16 h8 __attribute__((ext_vector_type(8)));

constexpr int D = 2048, SEQ = 8192, CTX = 256, MROWS = SEQ + CTX, DEPTH = 4, DFF = 5632;
constexpr int LRU_W = 1024, HY_W = 1024, IN_COLS = 5120, NMODC = 9 * D;
constexpr int GRID_W = 64, GRID_R = SEQ / GRID_W;
constexpr int FFTN = 16384, SPEC_PITCH = 8200;
constexpr float EPS = 1e-6f;
constexpr int NCHUNK = MROWS / 32;

constexpr size_t al256(size_t x) { return (x + 255) & ~(size_t)255; }
constexpr size_t WS_CTL = 0, CTL_BYTES = 1u << 20;
constexpr size_t WS_WUP = WS_CTL + CTL_BYTES;
constexpr size_t WS_WDN = WS_WUP + (size_t)DEPTH * 2 * 2 * DFF * D * 2;
constexpr size_t WS_WIN = WS_WDN + (size_t)DEPTH * 2 * D * DFF * 2;
constexpr size_t WS_WOUT = WS_WIN + (size_t)DEPTH * IN_COLS * D * 2;
constexpr size_t WS_WLRU = WS_WOUT + (size_t)DEPTH * D * D * 2;
constexpr size_t WS_MODS = WS_WLRU + (size_t)DEPTH * 4096 * 256 * 2;
constexpr size_t WS_SP8 = al256(WS_MODS + (size_t)DEPTH * 2 * NMODC * 4);
constexpr size_t WS_KTC = WS_SP8 + (size_t)DEPTH * 2 * 1024 * 4;
constexpr size_t WS_W4P = WS_KTC + (size_t)DEPTH * 2048 * 256 * 4;
constexpr size_t WS_SPEC = WS_W4P + (size_t)DEPTH * 64 * 4 * 2 * 64 * 16;
constexpr size_t WS_NORM = WS_CTL + 65536;
constexpr size_t WS_X = WS_SPEC + (size_t)DEPTH * 512 * SPEC_PITCH * 8;
constexpr size_t WS_U = WS_X + (size_t)MROWS * D * 4;
constexpr size_t WS_H = WS_U + (size_t)MROWS * D * 2;
constexpr size_t WS_CARRY = WS_H + (size_t)MROWS * DFF * 2;
constexpr size_t WS_SUMA = WS_CARRY + (size_t)2 * NCHUNK * 1024 * 4;
constexpr size_t WS_SUMB = WS_SUMA + (size_t)2 * NCHUNK * 1024 * 4;
constexpr size_t WS_WCTX = WS_SUMB + (size_t)2 * NCHUNK * 1024 * 4;
constexpr size_t WS_YCTX = WS_WCTX + (size_t)CTX * 1024 * 4;
constexpr size_t WS_SLAB = WS_YCTX + (size_t)CTX * 1024 * 4;
constexpr size_t WS_BIG = WS_SLAB + (size_t)11 * CTX * D * 4;
constexpr size_t WS_KT8 = WS_BIG;
constexpr size_t WS_P = WS_BIG;
constexpr size_t WS_CVF = WS_P + (size_t)MROWS * IN_COLS * 2;
constexpr size_t WS_CVB = WS_CVF + (size_t)MROWS * 1024 * 4;
constexpr size_t WS_X0 = WS_CVB + (size_t)MROWS * 1024 * 2;
constexpr size_t WS_WT = WS_X0 + (size_t)MROWS * 1024 * 4;
constexpr size_t WS_YT = WS_WT + (size_t)1024 * SEQ * 2;
constexpr size_t WS_ABP = WS_YT + (size_t)1024 * SEQ * 2;
constexpr size_t WS_END_ACT = WS_ABP + (size_t)2 * MROWS * 1024 * 4;
constexpr size_t WS_END_KT8 = WS_KT8 + (size_t)DEPTH * 2048 * 8192 * 4;
constexpr size_t WS_END = WS_END_ACT > WS_END_KT8 ? WS_END_ACT : WS_END_KT8;
static_assert(WS_END < (size_t)2300 * 1000 * 1000, "workspace map exceeds the guaranteed d_ws size");

constexpr int LDS_MAIN = 131072, LDS_BYTES = 147456;
constexpr int LDS_EXTRA = LDS_MAIN, LDS_CTLW = LDS_BYTES - 64;

namespace pg8 {
typedef unsigned short bf16_t;
typedef unsigned u32x4 __attribute__((ext_vector_type(4)));
constexpr int BM = 256, BK = 64, HALF = 128, HTB = HALF * BK * 2, STAGE_BYTES = 8 * HTB, NXCD = 8, WGM = 8;
__host__ __device__ __forceinline__ int lds_byte(int r, int c) { const int st = (r >> 4) * 2 + (c >> 5), rr = r & 15, cc = c & 31, ob = rr * 64 + cc * 2; return st * 1024 + (ob ^ (((ob >> 9) & 1) << 5)); }
__host__ __device__ __forceinline__ void stage_rc(int b, int& R, int& C) { const int st = b / 1024, sb = b % 1024, swz = sb ^ (((sb >> 9) & 1) << 5); R = (st >> 1) * 16 + swz / 64; C = (st & 1) * 32 + (swz % 64) / 2; }
__host__ __device__ __forceinline__ int perm32(int rho) { const int n = rho >> 4, i = rho & 15; return 8 * (i >> 2) + 4 * n + (i & 3); }
struct Unit { int pm, pn; };
struct Gemm { const bf16_t* A; const bf16_t* Bt; int M, N, K, lda, ldb, agrp_n, agrp_off, bmod, bgrp_off; };
struct StaticOrder {
    int nM, nN, nwg, G, c, rev;
    __host__ __device__ void init(int M, int N, int G_, int c_, int rev_ = 0) { nM = M / BM; nN = N / BM; nwg = nM * nN; G = G_; c = c_; rev = rev_; }
    __host__ __device__ bool next(int i, Unit& u) const {
        const long L = (long)i * G + c; if (L >= nwg) return false;
        int wgid = (int)L; { const int q = nwg / NXCD, r = nwg % NXCD, xcd = wgid % NXCD; int off = wgid / NXCD; if (rev) off = (xcd < r ? q + 1 : q) - 1 - off;
            wgid = (xcd < r ? xcd * (q + 1) : r * (q + 1) + (xcd - r) * q) + off; }
        const int nig = WGM * nN, gid = wgid / nig, fm = gid * WGM, gsz = (nM - fm) < WGM ? (nM - fm) : WGM;
        u.pm = fm + ((wgid % nig) % gsz); u.pn = (wgid % nig) / gsz; return true;
    }
};
__device__ __forceinline__ unsigned cvt_pk_bf16(float lo, float hi) { unsigned r; asm volatile("v_cvt_pk_bf16_f32 %0, %1, %2" : "=v"(r) : "v"(lo), "v"(hi)); return r; }

#ifndef PG8_SP2
#define PG8_SP2 true
#endif
template <class Epi, bool ALIGN_EPI = true, bool SP2 = PG8_SP2>
__device__ __forceinline__ void gemm_phase(LAS unsigned char* lds, const Gemm g, const StaticOrder& S, const Epi& E) {
    int tid = threadIdx.x; asm volatile("" : "+v"(tid));
    const int wid = __builtin_amdgcn_readfirstlane(tid >> 6), lane = tid & 63, wr = wid >> 2, wc = wid & 3, fr = lane & 15, fq = lane >> 4;
    const int K = g.K, nt = K / BK;
    unsigned voffA[2], voffB[2];
#pragma unroll
    for (int i = 0; i < 2; ++i) { int R, C; stage_rc(tid * 16 + i * 8192, R, C); const int Rb = Epi::PERM ? ((R & ~31) + perm32(R & 31)) : R;
        voffA[i] = (unsigned)(R * g.lda + C) * 2u; voffB[i] = (unsigned)(Rb * g.ldb + C) * 2u; }
    const size_t kstep = (size_t)(BK * 2);
    const size_t hstepA = (size_t)HALF * g.lda * 2, hstepB = (size_t)HALF * g.ldb * 2;
    const size_t tstepA = 2 * hstepA, tstepB = 2 * hstepB;
    const unsigned ldsw = (unsigned)wid * 1024u;
    const int aoff = lds_byte(wr * 64 + fr, fq * 8), boff = lds_byte(wc * 32 + fr, fq * 8);
#define PG8_SA(b, h) (((b) * 2 + (h)) * HTB)
#define PG8_SB(b, h) ((4 + (b) * 2 + (h)) * HTB)
#define PG8_STAGE(bufoff, gbase, voff) do { _Pragma("unroll") for (int _i = 0; _i < 2; ++_i) \
        __builtin_amdgcn_global_load_lds((const GAS unsigned*)((const char*)(gbase) + (voff)[_i]), (LAS unsigned*)(lds + (bufoff) + ldsw + _i * 8192), 16, 0, 0); } while (0)
#define PG8_LDA(dst, b, h) do { _Pragma("unroll") for (int m = 0; m < 4; ++m) _Pragma("unroll") for (int k = 0; k < 2; ++k) dst[m][k] = *(const LAS bf16x8*)(lds + PG8_SA(b, h) + aoff + m * 2048 + k * 1024); } while (0)
#define PG8_LDB(dst, b, h) do { _Pragma("unroll") for (int n = 0; n < 2; ++n) _Pragma("unroll") for (int k = 0; k < 2; ++k) dst[n][k] = *(const LAS bf16x8*)(lds + PG8_SB(b, h) + boff + n * 2048 + k * 1024); } while (0)
#define PG8_MMA(ai, bj, At, Bt) do { __builtin_amdgcn_s_setprio(1); _Pragma("unroll") for (int m = 0; m < 4; ++m) _Pragma("unroll") for (int n = 0; n < 2; ++n) _Pragma("unroll") for (int k = 0; k < 2; ++k) \
        acc[ai][bj][m][n] = __builtin_amdgcn_mfma_f32_16x16x32_bf16(Bt[n][k], At[m][k], acc[ai][bj][m][n], 0, 0, 0); __builtin_amdgcn_s_setprio(0); } while (0)
#define PG8_WAIT_V(n) asm volatile("s_waitcnt vmcnt(" #n ")" ::: "memory")
#define PG8_WAIT_L(n) asm volatile("s_waitcnt lgkmcnt(" #n ")" ::: "memory")
#define PG8_BAR __builtin_amdgcn_s_barrier()
#define PG8_SCHED __builtin_amdgcn_sched_barrier(0)
    Unit cur, nxt; int ui = 0;
    if (!S.next(0, cur)) return;
    f32x4 acc[2][2][4][2];
#pragma unroll
    for (int a = 0; a < 2; ++a)
#pragma unroll
        for (int b = 0; b < 2; ++b)
#pragma unroll
            for (int m = 0; m < 4; ++m)
#pragma unroll
                for (int n = 0; n < 2; ++n) acc[a][b][m][n] = (f32x4){0.f, 0.f, 0.f, 0.f};
    bf16x8 At[4][2], B0[2][2], B1[2][2];
    const char* cA = (const char*)g.A + (size_t)cur.pm * tstepA + (size_t)((cur.pn / g.agrp_n) * g.agrp_off) * 2; const char* cB = (const char*)g.Bt + (size_t)(cur.pn % g.bmod) * tstepB + (size_t)((cur.pn / g.bmod) * g.bgrp_off) * 2;
    if constexpr (SP2) {
    PG8_STAGE(PG8_SB(0, 0), cB, voffB); PG8_STAGE(PG8_SB(0, 1), cB + hstepB, voffB); PG8_STAGE(PG8_SA(0, 0), cA, voffA); PG8_STAGE(PG8_SA(0, 1), cA + hstepA, voffA);
    if (wr == 1) PG8_BAR;
    PG8_WAIT_V(2); PG8_BAR;
    PG8_STAGE(PG8_SB(1, 0), cB + kstep, voffB); PG8_STAGE(PG8_SA(1, 0), cA + kstep, voffA); PG8_STAGE(PG8_SB(1, 1), cB + hstepB + kstep, voffB);
    PG8_WAIT_V(6); PG8_BAR;
    } else {
    PG8_STAGE(PG8_SB(0, 0), cB, voffB); PG8_STAGE(PG8_SA(0, 0), cA, voffA); PG8_STAGE(PG8_SB(0, 1), cB + hstepB, voffB); PG8_STAGE(PG8_SA(0, 1), cA + hstepA, voffA);
    if (wr == 1) PG8_BAR;
    PG8_WAIT_V(4); PG8_BAR;
    PG8_STAGE(PG8_SB(1, 0), cB + kstep, voffB); PG8_STAGE(PG8_SA(1, 0), cA + kstep, voffA); PG8_STAGE(PG8_SB(1, 1), cB + hstepB + kstep, voffB);
    PG8_WAIT_V(6); PG8_BAR;
    }
    for (;;) {
        const bool has_next = S.next(ui + 1, nxt);
        const char* nA = has_next ? (const char*)g.A + (size_t)nxt.pm * tstepA + (size_t)((nxt.pn / g.agrp_n) * g.agrp_off) * 2 : cA;
        const char* nB = has_next ? (const char*)g.Bt + (size_t)(nxt.pn % g.bmod) * tstepB + (size_t)((nxt.pn / g.bmod) * g.bgrp_off) * 2 : cB;
#pragma unroll 1
        for (int t = 0; t < nt; t += 2) {
            const bool last = (t == nt - 2);
            const char* a1 = cA + (size_t)(t + 1) * kstep;
            const char* a2 = last ? nA : cA + (size_t)(t + 2) * kstep; const char* b2 = last ? nB : cB + (size_t)(t + 2) * kstep;
            const char* a3 = a2 + kstep; const char* b3 = b2 + kstep;
            if constexpr (SP2) {
            PG8_LDB(B0, 0, 0); PG8_LDB(B1, 0, 1); PG8_SCHED; PG8_LDA(At, 0, 0); PG8_STAGE(PG8_SA(1, 1), a1 + hstepA, voffA);
            PG8_WAIT_V(8); PG8_WAIT_L(0); PG8_BAR; PG8_MMA(0, 0, At, B0); PG8_MMA(0, 1, At, B1); PG8_BAR; PG8_SCHED;
            PG8_LDA(At, 0, 1); PG8_STAGE(PG8_SB(0, 0), b2, voffB); PG8_STAGE(PG8_SB(0, 1), b2 + hstepB, voffB); PG8_STAGE(PG8_SA(0, 0), a2, voffA);
            PG8_WAIT_V(8); PG8_WAIT_L(0); PG8_BAR; PG8_MMA(1, 0, At, B0); PG8_MMA(1, 1, At, B1); PG8_BAR; PG8_SCHED;
            PG8_LDB(B0, 1, 0); PG8_LDB(B1, 1, 1); PG8_SCHED; PG8_LDA(At, 1, 0); PG8_STAGE(PG8_SA(0, 1), a2 + hstepA, voffA);
            PG8_WAIT_V(8); PG8_WAIT_L(0); PG8_BAR; PG8_MMA(0, 0, At, B0); PG8_MMA(0, 1, At, B1); PG8_BAR; PG8_SCHED;
            PG8_LDA(At, 1, 1); PG8_STAGE(PG8_SB(1, 0), b3, voffB); PG8_STAGE(PG8_SB(1, 1), b3 + hstepB, voffB); PG8_STAGE(PG8_SA(1, 0), a3, voffA);
            PG8_WAIT_V(8); PG8_WAIT_L(0); PG8_BAR; PG8_MMA(1, 0, At, B0); PG8_MMA(1, 1, At, B1); PG8_BAR; PG8_SCHED;
            } else {
            PG8_LDB(B0, 0, 0); PG8_SCHED; PG8_LDA(At, 0, 0); PG8_STAGE(PG8_SA(1, 1), a1 + hstepA, voffA);
            PG8_WAIT_L(8); PG8_BAR; PG8_WAIT_L(0); PG8_MMA(0, 0, At, B0); PG8_BAR; PG8_SCHED;
            PG8_LDB(B1, 0, 1); PG8_STAGE(PG8_SB(0, 0), b2, voffB);
            PG8_BAR; PG8_WAIT_L(0); PG8_MMA(0, 1, At, B1); PG8_BAR;
            PG8_LDA(At, 0, 1); PG8_STAGE(PG8_SA(0, 0), a2, voffA);
            PG8_BAR; PG8_WAIT_L(0); PG8_MMA(1, 0, At, B0); PG8_BAR; PG8_SCHED;
            PG8_STAGE(PG8_SB(0, 1), b2 + hstepB, voffB);
            PG8_WAIT_V(6); PG8_BAR; PG8_MMA(1, 1, At, B1); PG8_BAR;
            PG8_LDB(B0, 1, 0); PG8_SCHED; PG8_LDA(At, 1, 0); PG8_STAGE(PG8_SA(0, 1), a2 + hstepA, voffA);
            PG8_WAIT_L(8); PG8_BAR; PG8_WAIT_L(0); PG8_MMA(0, 0, At, B0); PG8_BAR; PG8_SCHED;
            PG8_LDB(B1, 1, 1); PG8_STAGE(PG8_SB(1, 0), b3, voffB);
            PG8_BAR; PG8_WAIT_L(0); PG8_MMA(0, 1, At, B1); PG8_BAR;
            PG8_LDA(At, 1, 1); PG8_STAGE(PG8_SA(1, 0), a3, voffA);
            PG8_BAR; PG8_WAIT_L(0); PG8_MMA(1, 0, At, B0); PG8_BAR; PG8_SCHED;
            PG8_STAGE(PG8_SB(1, 1), b3 + hstepB, voffB);
            PG8_WAIT_V(6); PG8_BAR; PG8_MMA(1, 1, At, B1); PG8_BAR;
            }
        }
        if constexpr (ALIGN_EPI) { if (wr == 0) PG8_BAR; }
        E(acc, cur, wr, wc, fr, fq);
#ifdef DBG_EPI2
        if (Epi::PERM) { asm volatile("s_waitcnt vmcnt(0)" ::: "memory"); E(acc, cur, wr, wc, fr, fq); }
#endif
        if (!has_next) break;
#pragma unroll
        for (int a = 0; a < 2; ++a)
#pragma unroll
            for (int b = 0; b < 2; ++b)
#pragma unroll
                for (int m = 0; m < 4; ++m)
#pragma unroll
                    for (int n = 0; n < 2; ++n) acc[a][b][m][n] = (f32x4){0.f, 0.f, 0.f, 0.f};
        cur = nxt; cA = nA; cB = nB; ++ui;
        if constexpr (ALIGN_EPI) { if (wr == 1) PG8_BAR; }
    }
    PG8_WAIT_V(0);
    if constexpr (!ALIGN_EPI) { if (wr == 0) PG8_BAR; }
    PG8_BAR;
#undef PG8_SA
#undef PG8_SB
#undef PG8_STAGE
#undef PG8_LDA
#undef PG8_LDB
#undef PG8_MMA
#undef PG8_WAIT_V
#undef PG8_WAIT_L
#undef PG8_BAR
#undef PG8_SCHED
}
}

__device__ __forceinline__ unsigned f2bf(float f) { unsigned u = __builtin_bit_cast(unsigned, f); return (u + 0x7fffu + ((u >> 16) & 1u)) >> 16; }
__device__ __forceinline__ unsigned pk2(float lo, float hi) { return f2bf(lo) | (f2bf(hi) << 16); }
__device__ __forceinline__ float sigmoid_f(float x) { return 1.0f / (1.0f + __expf(-x)); }
__device__ __forceinline__ float silu_f(float x) { return x / (1.0f + __expf(-x)); }
__device__ __forceinline__ float gelu_tanh_f(float x) { const float u = 0.7978845608028654f * (x + 0.044715f * x * x * x); const float th = 1.0f - 2.0f * __builtin_amdgcn_rcpf(1.0f + __expf(2.0f * u)); return 0.5f * x * (1.0f + th); }
__device__ __forceinline__ float wave_sum(float v) {
#pragma unroll
    for (int o = 1; o < 64; o <<= 1) v += __shfl_xor(v, o);
    return v;
}
#define LDS_WAIT() asm volatile("s_waitcnt lgkmcnt(0)" ::: "memory")
__device__ __forceinline__ unsigned pack_h2(float lo, float hi) { const _Float16 a = (_Float16)lo, b = (_Float16)hi; return (unsigned)__builtin_bit_cast(unsigned short, a) | ((unsigned)__builtin_bit_cast(unsigned short, b) << 16); }
__device__ __forceinline__ float h_lo(unsigned w) { return (float)__builtin_bit_cast(_Float16, (unsigned short)(w & 0xffffu)); }
__device__ __forceinline__ float lru_step(float la, float bp, float h) { const float a = __expf(la); return a * h + __builtin_amdgcn_sqrtf(fmaxf(1.0f - a * a, 0.f)) * bp; }
__device__ __forceinline__ float h_hi(unsigned w) { return (float)__builtin_bit_cast(_Float16, (unsigned short)(w >> 16)); }
__device__ __forceinline__ float bf_lo(unsigned w) { return __builtin_bit_cast(float, w << 16); }
__device__ __forceinline__ float bf_hi2(unsigned w) { return __builtin_bit_cast(float, w & 0xffff0000u); }

__device__ __forceinline__ void st16_wt(void* p, v4u v) { asm volatile("global_store_dwordx4 %0, %1, off sc1\n\ts_nop 1" ::"v"(p), "v"(v) : "memory"); }
struct EpiSwiGLU {
    static constexpr bool PERM = true;
    bf16* H; unsigned* cnt;
    __device__ __forceinline__ void operator()(const f32x4 (&acc)[2][2][4][2], const pg8::Unit& u, int wr, int wc, int fr, int fq) const {
        const int row0 = u.pm * 256 + wr * 64 + fr, col0 = u.pn * 128 + wc * 32 + 8 * fq;
#pragma unroll
        for (int ai = 0; ai < 2; ++ai)
#pragma unroll
            for (int m = 0; m < 4; ++m) {
                bf16* rowp = H + (size_t)(row0 + ai * 128 + m * 16) * DFF + col0;
                float o[8];
#pragma unroll
                for (int n = 0; n < 2; ++n)
#pragma unroll
                    for (int j = 0; j < 4; ++j) { const float gv = acc[ai][0][m][n][j], uv = acc[ai][1][m][n][j]; o[n * 4 + j] = gv * __builtin_amdgcn_rcpf(1.0f + __expf(-gv)) * uv; }
                v4u w; w.x = pg8::cvt_pk_bf16(o[0], o[1]); w.y = pg8::cvt_pk_bf16(o[2], o[3]); w.z = pg8::cvt_pk_bf16(o[4], o[5]); w.w = pg8::cvt_pk_bf16(o[6], o[7]);
                st16_wt(rowp, w);
            }
        if (u.pm == MROWS / 256 - 1) {
            asm volatile("s_waitcnt vmcnt(0)" ::: "memory");
            if ((fr | fq) == 0) (void)__hip_atomic_fetch_add(cnt, 1u, __ATOMIC_RELAXED, __HIP_MEMORY_SCOPE_AGENT);
        }
    }
};
struct EpiResid {
    static constexpr bool PERM = true;
    xh* X; const float* gate_l; float sc; int permute;
    __device__ __forceinline__ void operator()(const f32x4 (&acc)[2][2][4][2], const pg8::Unit& u, int wr, int wc, int fr, int fq) const {
        const int row0 = u.pm * 256 + wr * 64 + fr, col0 = u.pn * 256 + wc * 32 + 8 * fq;
        f32x4 gv[2][2];
#pragma unroll
        for (int bj = 0; bj < 2; ++bj)
#pragma unroll
            for (int n = 0; n < 2; ++n) gv[bj][n] = *(const f32x4*)(gate_l + col0 + bj * 128 + n * 4) * sc;
#pragma unroll
        for (int ai = 0; ai < 2; ++ai) {
            xh* rowp[4]; h8 xv[4][2];
#pragma unroll
            for (int m = 0; m < 4; ++m) { int row = row0 + ai * 128 + m * 16; if (permute && row < SEQ) row = (row & (GRID_R - 1)) * GRID_W + (row >> 7); rowp[m] = X + (size_t)row * D + col0; }
#pragma unroll
            for (int m = 0; m < 4; ++m)
#pragma unroll
                for (int bj = 0; bj < 2; ++bj) xv[m][bj] = *(const h8*)(rowp[m] + bj * 128);
#pragma unroll
            for (int m = 0; m < 4; ++m)
#pragma unroll
                for (int bj = 0; bj < 2; ++bj) {
                    const f32x4 lo = __builtin_convertvector(__builtin_shufflevector(xv[m][bj], xv[m][bj], 0, 1, 2, 3), f32x4) + gv[bj][0] * acc[ai][bj][m][0];
                    const f32x4 hi = __builtin_convertvector(__builtin_shufflevector(xv[m][bj], xv[m][bj], 4, 5, 6, 7), f32x4) + gv[bj][1] * acc[ai][bj][m][1];
                    const h4 l4 = __builtin_convertvector(lo, h4), h4v = __builtin_convertvector(hi, h4);
                    const h8 o8 = __builtin_shufflevector(l4, h4v, 0, 1, 2, 3, 4, 5, 6, 7);
                    st16_wt(rowp[m] + bj * 128, __builtin_bit_cast(v4u, o8));
                }
        }
    }
};
struct EpiSlab {
    static constexpr bool PERM = false;
    xh* S; const float* gate; float sc; int ntile;
    __device__ __forceinline__ void operator()(const f32x4 (&acc)[2][2][4][2], const pg8::Unit& u, int wr, int wc, int fr, int fq) const {
        const int row0 = u.pm * 256 + wr * 64 + fr, col0 = (u.pn % ntile) * 256 + wc * 32 + 4 * fq;
        xh* base = S + (size_t)(u.pn / ntile) * CTX * D;
#pragma unroll
        for (int bj = 0; bj < 2; ++bj)
#pragma unroll
            for (int n = 0; n < 2; ++n) { const f32x4 gv = *(const f32x4*)(gate + col0 + bj * 128 + n * 16) * sc;
#pragma unroll
                for (int ai = 0; ai < 2; ++ai)
#pragma unroll
                    for (int m = 0; m < 4; ++m) *(h4*)(base + (size_t)(row0 + ai * 128 + m * 16) * D + col0 + bj * 128 + n * 16) = __builtin_convertvector(gv * acc[ai][bj][m][n], h4); }
    }
};
struct EpiBf16Out {
    static constexpr bool PERM = true;
    bf16* O; int ldc;
    __device__ __forceinline__ void operator()(const f32x4 (&acc)[2][2][4][2], const pg8::Unit& u, int wr, int wc, int fr, int fq) const {
        const int row0 = u.pm * 256 + wr * 64 + fr, col0 = u.pn * 256 + wc * 32 + 8 * fq;
#pragma unroll
        for (int ai = 0; ai < 2; ++ai)
#pragma unroll
            for (int m = 0; m < 4; ++m) { bf16* rowp = O + (size_t)(row0 + ai * 128 + m * 16) * ldc + col0;
#pragma unroll
                for (int bj = 0; bj < 2; ++bj) { const f32x4 v0 = acc[ai][bj][m][0], v1 = acc[ai][bj][m][1];
                    v4u w; w.x = pg8::cvt_pk_bf16(v0[0], v0[1]); w.y = pg8::cvt_pk_bf16(v0[2], v0[3]); w.z = pg8::cvt_pk_bf16(v1[0], v1[1]); w.w = pg8::cvt_pk_bf16(v1[2], v1[3]);
                    st16_wt(rowp + bj * 128, w); } }
    }
};
struct EpiF32 {
    static constexpr bool PERM = false;
    float* C; int ldc;
    __device__ __forceinline__ void operator()(const f32x4 (&acc)[2][2][4][2], const pg8::Unit& u, int wr, int wc, int fr, int fq) const {
        const int row0 = u.pm * 256 + wr * 64 + fr, col0 = u.pn * 256 + wc * 32 + 4 * fq;
#pragma unroll
        for (int ai = 0; ai < 2; ++ai)
#pragma unroll
            for (int m = 0; m < 4; ++m) { float* rowp = C + (size_t)(row0 + ai * 128 + m * 16) * ldc + col0;
#pragma unroll
                for (int bj = 0; bj < 2; ++bj)
#pragma unroll
                    for (int n = 0; n < 2; ++n) *(f32x4*)(rowp + bj * 128 + n * 16) = acc[ai][bj][m][n]; }
    }
};
struct EpiGates {
    static constexpr bool PERM = false;
    const float* ba; const float* bx; const float* sp8;
    const bf16* cvb; unsigned* ABP;
    __device__ __forceinline__ void operator()(const f32x4 (&acc)[2][2][4][2], const pg8::Unit& u, int wr, int wc, int fr, int fq) const {
        const int head = u.pn >> 2, d = (u.pn >> 1) & 1, c2 = u.pn & 1;
        const int row0 = u.pm * 256 + wr * 64 + fr, ch0 = head * 256 + c2 * 128 + wc * 32 + 4 * fq;
        v2u cvw[2][2][4];
#pragma unroll
        for (int n = 0; n < 2; ++n)
#pragma unroll
            for (int ai = 0; ai < 2; ++ai)
#pragma unroll
                for (int m = 0; m < 4; ++m) cvw[n][ai][m] = *(const v2u*)(cvb + (size_t)(row0 + ai * 128 + m * 16) * 1024 + ch0 + n * 16);
#pragma unroll
        for (int n = 0; n < 2; ++n) {
            const f32x4 vba = *(const f32x4*)(ba + d * 1024 + ch0 + n * 16), vbx = *(const f32x4*)(bx + d * 1024 + ch0 + n * 16), vsp = *(const f32x4*)(sp8 + d * 1024 + ch0 + n * 16);
#pragma unroll
            for (int ai = 0; ai < 2; ++ai)
#pragma unroll
                for (int m = 0; m < 4; ++m) {
                    const size_t off = (size_t)(row0 + ai * 128 + m * 16) * 1024 + ch0 + n * 16;
                    const v2u cw = cvw[n][ai][m]; const f32x4 cv = {bf_lo(cw.x), bf_hi2(cw.x), bf_lo(cw.y), bf_hi2(cw.y)};
                    v4u pk;
#pragma unroll
                    for (int j = 0; j < 4; ++j) {
                        const float za = fminf(fmaxf(acc[ai][0][m][n][j] + vba[j], -60.f), 60.f), zx = fminf(fmaxf(acc[ai][1][m][n][j] + vbx[j], -60.f), 60.f);
                        const float pa = 1.0f + __expf(-za), px = 1.0f + __expf(-zx), rp = __builtin_amdgcn_rcpf(pa * px);
                        const float r = px * rp, ig = pa * rp;
                        const float la = -r * vsp[j];
                        pk[j] = pack_h2(la, ig * cv[j]);
                    }
                    st16_wt(ABP + (size_t)d * MROWS * 1024 + off, pk);
                }
        }
    }
};

#define XB_TMO      128
#define XB_XCNT(j)  (256  + 64 * (j))
#define XB_XSUB(j)  (1280 + 64 * (j))
#define XB_XGEN(j)  (2304 + 64 * (j))
#define XB_TOP      3328
#define XB_TOPGEN   3392
#define XCD_BAR_WORDS 3456
#define XB_SPIN_CAP (1u << 18)
__device__ __forceinline__ unsigned xb_ld(unsigned* p)              { return __hip_atomic_load(p, __ATOMIC_RELAXED, __HIP_MEMORY_SCOPE_AGENT); }
__device__ __forceinline__ unsigned xb_add(unsigned* p, unsigned v) { return __hip_atomic_fetch_add(p, v, __ATOMIC_RELAXED, __HIP_MEMORY_SCOPE_AGENT); }
__device__ __forceinline__ unsigned xb_xcc_id() { return (unsigned)__builtin_amdgcn_s_getreg((3 << 11) | 20) & 0xFu; }
#define XB_SPIN(cond, bar) do { unsigned _sp = 0; while (cond) { __builtin_amdgcn_s_sleep(1); \
    if ((++_sp & 255u) == 0u) { if (xb_ld(&(bar)[XB_TMO])) break; if (_sp > XB_SPIN_CAP) { atomicAdd(&(bar)[XB_TMO], 1u); break; } } } } while (0)
struct XcdBarrier { unsigned* bar; unsigned x; volatile LAS unsigned* st; };
__device__ __forceinline__ XcdBarrier xcd_barrier_post(unsigned* bar, volatile LAS unsigned* st) {
    XcdBarrier b; b.bar = bar; b.x = xb_xcc_id(); b.st = st;
    if (threadIdx.x == 0) (void)xb_add(&bar[XB_XCNT(b.x)], 1u);
    return b;
}
__device__ __forceinline__ void xcd_barrier_complete(unsigned* bar, unsigned x, unsigned& nloc, unsigned& nx) {
    const unsigned G = gridDim.x * gridDim.y * gridDim.z;
    unsigned sum, cnt, mine, sp = 0u;
    for (;;) {
        sum = 0u; cnt = 0u; mine = 0u;
#pragma unroll
        for (unsigned j = 0; j < 16; ++j) { const unsigned c = xb_ld(&bar[XB_XCNT(j)]); sum += c; cnt += (c > 0u) ? 1u : 0u; mine = (j == x) ? c : mine; }
        if (sum == G) break;
        __builtin_amdgcn_s_sleep(1);
        if ((++sp & 255u) == 0u) { if (xb_ld(&bar[XB_TMO])) break; if (sp > XB_SPIN_CAP) { atomicAdd(&bar[XB_TMO], 1u); break; } }
    }
    nloc = mine > 0u ? mine : 1u; nx = cnt > 0u ? cnt : 1u;
}
__device__ __forceinline__ void xcd_barrier(const XcdBarrier& b) {
    asm volatile("s_waitcnt vmcnt(0)" ::: "memory");
    __syncthreads();
    if (threadIdx.x == 0) {
        unsigned* bar = b.bar;
        __builtin_amdgcn_s_waitcnt(0);
        unsigned nloc = b.st[0], nx = b.st[1];
        if (nloc == 0u) { xcd_barrier_complete(bar, b.x, nloc, nx); b.st[0] = nloc; b.st[1] = nx; }
        const unsigned old = xb_add(&bar[XB_XSUB(b.x)], 1u);
        const unsigned gen = old / nloc;
        if (old + 1u == (gen + 1u) * nloc) {
            __builtin_amdgcn_fence(__ATOMIC_RELEASE, "agent");
            asm volatile("s_waitcnt vmcnt(0)" ::: "memory");
            const unsigned og = xb_add(&bar[XB_TOP], 1u);
            const unsigned tg = og / nx;
            if (og + 1u == (tg + 1u) * nx) xb_add(&bar[XB_TOPGEN], 1u);
            else XB_SPIN(xb_ld(&bar[XB_TOPGEN]) == tg, bar);
            __builtin_amdgcn_fence(__ATOMIC_ACQUIRE, "agent");
            xb_add(&bar[XB_XGEN(b.x)], 1u);
            asm volatile("s_waitcnt vmcnt(0)" ::: "memory");
        } else {
            XB_SPIN(xb_ld(&bar[XB_XGEN(b.x)]) == gen, bar);
            __builtin_amdgcn_fence(__ATOMIC_ACQUIRE, "agent");
            asm volatile("s_waitcnt vmcnt(0)" ::: "memory");
        }
    }
    __syncthreads();
}

enum InIdx { I_X = 0, I_C, I_CTX, I_CCTX, I_ADAW, I_ADAB, I_NORMG, I_WG, I_WU, I_WD, I_WIN, I_WOUT, I_OUTG, I_LCW, I_LCB, I_WA, I_BA, I_WX, I_BX, I_LAM,
             I_HCW, I_HCB, I_HBIAS, I_FW1, I_FB1, I_FW2, I_FB2, I_FW3, I_FB3, I_FW4, I_FB4, I_FREQ, I_FINALG, N_IN };
struct Args { const float* in[N_IN]; float* out; unsigned char* ws; int ph_lo, ph_hi; };
static_assert(sizeof(Args) == (N_IN + 2) * 8 + 8, "Args has no padding");

constexpr int PH_PRO0 = 0, PH_PRO1 = 1, PH_PRO2 = 2, PH_LAYER0 = 3, PH_PER_LAYER = 14, PH_FINAL = PH_LAYER0 + DEPTH * PH_PER_LAYER, N_PHASES = PH_FINAL + 1;

__device__ __forceinline__ void transpose_item(const float* W, int N, bf16* WT, int ldk, int dest_row0, int k0, int n0, LAS float* scr, int lane) {
    float wv_[32];
#pragma unroll
    for (int i = 0; i < 32; ++i) wv_[i] = W[(size_t)(k0 + 2 * i + (lane >> 5)) * N + n0 + (lane & 31)];
#pragma unroll
    for (int i = 0; i < 32; ++i) scr[(2 * i + (lane >> 5)) * 33 + (lane & 31)] = wv_[i];
    LDS_WAIT(); asm volatile("" ::: "memory");
    const int c = lane & 7;
#pragma unroll
    for (int j = 0; j < 4; ++j) { const int n = (lane >> 3) + 8 * j; const LAS float* s = scr + (8 * c) * 33 + n;
        v4u o; o.x = pk2(s[0 * 33], s[1 * 33]); o.y = pk2(s[2 * 33], s[3 * 33]); o.z = pk2(s[4 * 33], s[5 * 33]); o.w = pk2(s[6 * 33], s[7 * 33]);
        *(v4u*)(WT + (size_t)(dest_row0 + n) * ldk + k0 + 8 * c) = o; }
    LDS_WAIT(); asm volatile("" ::: "memory");
}

constexpr int CONV_UP = 4 * 32 * 176, CONV_DN = 2 * 88 * 64, CONV_IN = 32 * 160, CONV_OUT = 32 * 64, CONV_LRU = 16 * 32, CONV_PER_LAYER = CONV_UP + CONV_DN + CONV_IN + CONV_OUT + CONV_LRU;
constexpr int CONV_T_UP = 80 * 8 * 4, CONV_T_WIN = 108 * 8 * 10, CONV_T_SC = 208 * 8 * 3, CONV_T_DN = 0, CONV_T_WO = 192 * 8 * 3;
constexpr int CONV_T0 = 0, CONV_T1 = CONV_T0 + CONV_T_UP, CONV_T2 = CONV_T1 + CONV_T_WIN, CONV_T3 = CONV_T2 + CONV_T_SC, CONV_T4 = CONV_T3 + CONV_T_UP;
constexpr int CONV_T5 = CONV_T4 + CONV_T_DN, CONV_T6 = CONV_T5 + CONV_T_WO, CONV_TAIL_END = CONV_T6 + CONV_T_DN;
static_assert(CONV_PER_LAYER == 41472 && CONV_TAIL_END <= CONV_PER_LAYER, "conversion item map");
__device__ __forceinline__ void conv_item(const Args& a, int l, int r, LAS float* scr, int lane) {
    if (r < CONV_UP) { const int mat = r / 5632, q = r % 5632, kb = q / 176, nb = q % 176, lf = l * 2 + (mat >> 1), g = mat & 1, n0 = 32 * nb;
        transpose_item((g ? a.in[I_WU] : a.in[I_WG]) + (size_t)lf * D * DFF, DFF, (bf16*)(a.ws + WS_WUP) + (size_t)lf * 2 * DFF * D, D, 256 * (n0 >> 7) + 128 * g + (n0 & 127), 64 * kb, n0, scr, lane); return; }
    r -= CONV_UP;
    if (r < CONV_DN) { const int mat = l * 2 + r / 5632, q = r % 5632, kb = q / 64, nb = q % 64;
        transpose_item(a.in[I_WD] + (size_t)mat * DFF * D, D, (bf16*)(a.ws + WS_WDN) + (size_t)mat * D * DFF, DFF, 32 * nb, 64 * kb, 32 * nb, scr, lane); return; }
    r -= CONV_DN;
    if (r < CONV_IN) { const int kb = r / 160, nb = r % 160;
        transpose_item(a.in[I_WIN] + (size_t)l * D * IN_COLS, IN_COLS, (bf16*)(a.ws + WS_WIN) + (size_t)l * IN_COLS * D, D, 32 * nb, 64 * kb, 32 * nb, scr, lane); return; }
    r -= CONV_IN;
    if (r < CONV_OUT) { const int kb = r / 64, nb = r % 64;
        transpose_item(a.in[I_WOUT] + (size_t)l * D * D, D, (bf16*)(a.ws + WS_WOUT) + (size_t)l * D * D, D, 32 * nb, 64 * kb, 32 * nb, scr, lane); return; }
    r -= CONV_OUT;
    { const int mat = r / 32, q = r % 32, kb = q / 8, nb = q % 8, n0 = 32 * nb;
      const int h = mat & 3, d = (mat >> 2) & 1, g = (mat >> 3) & 1;
      const float* src = (g ? a.in[I_WX] : a.in[I_WA]) + (size_t)((l * 2 + d) * 4 + h) * 65536;
      transpose_item(src, 256, (bf16*)(a.ws + WS_WLRU) + (size_t)l * 4096 * 256, 256, h * 1024 + (d * 2 + (n0 >> 7)) * 256 + g * 128 + (n0 & 127), 64 * kb, n0, scr, lane); }
}
__device__ __forceinline__ void conv_range(const Args& a, LAS unsigned char* lds, int l, int lo, int hi, int widx, int nw, int wave, int lane) {
    LAS float* scr = (LAS float*)(lds + wave * 8448);
    for (int r = lo + widx; r < hi; r += nw) conv_item(a, l, r, scr, lane);
}
__device__ __forceinline__ void pro_weights(const Args& a, LAS unsigned char* lds, int gw, int ngw, int wave, int lane) {
    LAS float* scr = (LAS float*)(lds + wave * 8448);
    constexpr int REST = CONV_PER_LAYER - CONV_TAIL_END, NITEMS = CONV_PER_LAYER + (DEPTH - 1) * REST;
    for (int it = gw; it < NITEMS; it += ngw) {
        if (it < CONV_PER_LAYER) conv_item(a, 0, it, scr, lane);
        else { const int q = it - CONV_PER_LAYER; conv_item(a, 1 + q / REST, CONV_TAIL_END + q % REST, scr, lane); }
    }
}

__device__ __forceinline__ void pro_mods(const Args& a, LAS unsigned char* lds, int bid, int nb, int tid) {
    LAS float* sl = (LAS float*)lds; LAS float* sc = sl + D; LAS float* red = sc + D;
    for (int i = tid; i < D; i += 512) { sl[i] = silu_f(a.in[I_C][i]); sc[i] = silu_f(a.in[I_CCTX][i]); }
    __syncthreads();
    const int cq = tid & 15, ks = tid >> 4;
    for (int it = bid; it < DEPTH * (NMODC / 64); it += nb) {
        const int l = it / (NMODC / 64), c0 = (it % (NMODC / 64)) * 64;
        const float* wp = a.in[I_ADAW] + ((size_t)l * D + ks * 64) * NMODC + c0 + 4 * cq;
        f32x4 al = {0.f, 0.f, 0.f, 0.f}, ac = {0.f, 0.f, 0.f, 0.f};
#pragma unroll 8
        for (int kk = 0; kk < 64; ++kk) { const f32x4 w = *(const f32x4*)(wp + (size_t)kk * NMODC); const float s1 = sl[ks * 64 + kk], s2 = sc[ks * 64 + kk]; al += w * s1; ac += w * s2; }
#pragma unroll
        for (int j = 0; j < 4; ++j) { red[(ks * 2 + 0) * 64 + cq * 4 + j] = al[j]; red[(ks * 2 + 1) * 64 + cq * 4 + j] = ac[j]; }
        __syncthreads();
        if (tid < 128) { const int which = tid >> 6, col = tid & 63; float s = a.in[I_ADAB][(size_t)l * NMODC + c0 + col];
            for (int k = 0; k < 32; ++k) s += red[(k * 2 + which) * 64 + col];
            ((float*)(a.ws + WS_MODS))[((size_t)l * 2 + which) * NMODC + c0 + col] = s; }
        __syncthreads();
    }
}

typedef float f32x16 __attribute__((ext_vector_type(16)));
__device__ __forceinline__ int accrow(int r, int h) { return (r & 3) + 8 * (r >> 2) + 4 * h; }
__device__ __forceinline__ float bf_hi(float x) { return __builtin_bit_cast(float, f2bf(x) << 16); }
__device__ __forceinline__ void pro_w4p(const Args& a, int gtid, int nthr) {
    for (int e = gtid; e < DEPTH * 64 * 4 * 64; e += nthr) {
        const int lane = e & 63, s_ = (e >> 6) & 3, cb = (e >> 8) & 63, l = e >> 14, i = lane & 31, h = lane >> 5;
        const float* w4 = a.in[I_FW4] + (size_t)l * 64 * 2048 + 32 * cb + i;
        unsigned hi[4], lo[4];
#pragma unroll
        for (int jj = 0; jj < 4; ++jj) { float v[2], vh[2], vl[2];
#pragma unroll
            for (int q = 0; q < 2; ++q) { const int j = 2 * jj + q, f = 32 * (s_ >> 1) + 16 * (s_ & 1) + 8 * (j >> 2) + 4 * h + (j & 3); v[q] = w4[(size_t)f * 2048]; vh[q] = bf_hi(v[q]); vl[q] = v[q] - vh[q]; }
            hi[jj] = f2bf(vh[0]) | (f2bf(vh[1]) << 16); lo[jj] = f2bf(vl[0]) | (f2bf(vl[1]) << 16); }
        v4u* dst = (v4u*)(a.ws + WS_W4P) + ((size_t)((l * 64 + cb) * 4 + s_) * 2) * 64 + lane;
        dst[0] = (v4u){hi[0], hi[1], hi[2], hi[3]}; dst[64] = (v4u){lo[0], lo[1], lo[2], lo[3]};
    }
}
__device__ __forceinline__ void pro_mods_wave(const Args& a, const LAS float* sl, const LAS float* sc, int widx, int nw, int lane) {
    const int cq = lane & 7, kp = lane >> 3;
    for (int it = widx; it < DEPTH * (NMODC / 32); it += nw) {
        const int l = it / (NMODC / 32), c0 = (it % (NMODC / 32)) * 32 + 4 * cq;
        const float* wp = a.in[I_ADAW] + ((size_t)l * D + kp) * NMODC + c0;
        f32x4 al = {0.f, 0.f, 0.f, 0.f}, ac = {0.f, 0.f, 0.f, 0.f};
#pragma unroll 16
        for (int kk = 0; kk < D / 8; ++kk) { const f32x4 w = *(const f32x4*)(wp + (size_t)kk * 8 * NMODC); const float s1 = sl[kp + 8 * kk], s2 = sc[kp + 8 * kk]; al += w * s1; ac += w * s2; }
#pragma unroll
        for (int j = 0; j < 4; ++j) {
#pragma unroll
            for (int o = 8; o < 64; o <<= 1) { al[j] += __shfl_xor(al[j], o); ac[j] += __shfl_xor(ac[j], o); } }
        if (lane < 8) { const f32x4 bb = *(const f32x4*)(a.in[I_ADAB] + (size_t)l * NMODC + c0);
            *(f32x4*)((float*)(a.ws + WS_MODS) + ((size_t)l * 2 + 0) * NMODC + c0) = al + bb; *(f32x4*)((float*)(a.ws + WS_MODS) + ((size_t)l * 2 + 1) * NMODC + c0) = ac + bb; }
    }
}
__device__ __forceinline__ void pro_filters(const Args& a, int bid, int nb, int wave, int lane, bool do_norm) {
    const int i = lane & 31, h = lane >> 5;
    for (int it = wave < 4 ? bid * 4 + wave : 4 * nb + (wave - 4) * nb + bid; it < DEPTH * 264; it += 8 * nb) {
        const int l = it / 264, q = it % 264, Lsel = q >= 256 ? 1 : 0, tile = Lsel ? q - 256 : q;
        const int L = Lsel ? CTX : SEQ, t = tile * 32 + i;
        const float tt = (float)t / (float)(L - 1), wv = 6.283185307179586f * (float)t / (float)L;
        const float* w1 = a.in[I_FW1] + l * 33 * 64; const float* b1 = a.in[I_FB1] + l * 64;
        const float* w2 = a.in[I_FW2] + l * 64 * 64; const float* b2 = a.in[I_FB2] + l * 64;
        const float* w3 = a.in[I_FW3] + l * 64 * 64; const float* b3 = a.in[I_FB3] + l * 64;
        const float* b4 = a.in[I_FB4] + l * 2048; const float* fr = a.in[I_FREQ] + l * 64;
        f32x16 c0, c1, d0, d1;
#pragma unroll
        for (int r = 0; r < 16; ++r) { c0[r] = b1[accrow(r, h)]; c1[r] = b1[32 + accrow(r, h)]; }
        float w1a[17], w1b[17];
        { int i1 = i; asm volatile("" : "+v"(i1));
#pragma unroll
          for (int s_ = 0; s_ < 17; ++s_) { const int k = 2 * s_ + h; w1a[s_] = k < 33 ? w1[k * 64 + i1] : 0.f; w1b[s_] = k < 33 ? w1[k * 64 + 32 + i1] : 0.f; } }
        __builtin_amdgcn_sched_barrier(0);
#pragma unroll
        for (int s_ = 0; s_ < 17; ++s_) {
            const int k = 2 * s_ + h; float z;
            if (s_ == 0) { z = h ? __cosf(wv * 1e-4f) : tt; }
            else { const int b = (k - 1) & 15; const float f = 1e-4f + (float)b * ((15.0f - 1e-4f) / 15.0f); z = (k <= 16) ? __cosf(wv * f) : -__sinf(wv * f); if (k > 32) z = 0.f; }
            c0 = __builtin_amdgcn_mfma_f32_32x32x2f32(w1a[s_], z, c0, 0, 0, 0); c1 = __builtin_amdgcn_mfma_f32_32x32x2f32(w1b[s_], z, c1, 0, 0, 0);
        }
#pragma unroll
        for (int r = 0; r < 16; ++r) { const int j = accrow(r, h); c0[r] = __sinf(fr[j] * c0[r]); c1[r] = __sinf(fr[32 + j] * c1[r]); }
#pragma unroll 1
        for (int layer = 0; layer < 2; ++layer) {
            const float* w = layer ? w3 : w2; const float* b = layer ? b3 : b2;
            int ii = i; asm volatile("" : "+v"(ii));
#pragma unroll
            for (int r = 0; r < 16; ++r) { d0[r] = b[accrow(r, h)]; d1[r] = b[32 + accrow(r, h)]; }
#pragma unroll
            for (int q4 = 0; q4 < 4; ++q4) {
                float wa[8], wb[8];
#pragma unroll
                for (int r = 0; r < 8; ++r) { const int kk = 32 * (q4 >> 1) + accrow(8 * (q4 & 1) + r, h); wa[r] = w[kk * 64 + ii]; wb[r] = w[kk * 64 + 32 + ii]; }
                __builtin_amdgcn_sched_barrier(0);
#pragma unroll
                for (int r = 0; r < 8; ++r) { const float cv = (q4 >> 1) ? c1[8 * (q4 & 1) + r] : c0[8 * (q4 & 1) + r]; d0 = __builtin_amdgcn_mfma_f32_32x32x2f32(wa[r], cv, d0, 0, 0, 0); d1 = __builtin_amdgcn_mfma_f32_32x32x2f32(wb[r], cv, d1, 0, 0, 0); }
                __builtin_amdgcn_sched_barrier(0);
            }
#pragma unroll
            for (int r = 0; r < 16; ++r) { const int j = accrow(r, h); c0[r] = __sinf(fr[j] * d0[r]); c1[r] = __sinf(fr[32 + j] * d1[r]); }
        }
        bf16x8 Bh[4], Bl[4];
#pragma unroll
        for (int s_ = 0; s_ < 4; ++s_) {
            unsigned wh[4], wl[4];
#pragma unroll
            for (int jj = 0; jj < 4; ++jj) { float v[2], vh[2];
#pragma unroll
                for (int q2 = 0; q2 < 2; ++q2) { const int r = 8 * (s_ & 1) + 2 * jj + q2; v[q2] = (s_ >> 1) ? c1[r] : c0[r]; vh[q2] = bf_hi(v[q2]); }
                wh[jj] = f2bf(vh[0]) | (f2bf(vh[1]) << 16); wl[jj] = f2bf(v[0] - vh[0]) | (f2bf(v[1] - vh[1]) << 16); }
            Bh[s_] = __builtin_bit_cast(bf16x8, (v4u){wh[0], wh[1], wh[2], wh[3]}); Bl[s_] = __builtin_bit_cast(bf16x8, (v4u){wl[0], wl[1], wl[2], wl[3]});
        }
        float* kT = Lsel ? (float*)(a.ws + WS_KTC) + (size_t)l * 2048 * CTX : (float*)(a.ws + WS_KT8) + (size_t)l * 2048 * SEQ;
        float* nrm = (float*)(a.ws + WS_NORM) + (size_t)(l * 2 + Lsel) * 2048;
        const v4u* w4p = (const v4u*)(a.ws + WS_W4P) + (size_t)l * 64 * 4 * 2 * 64 + lane;
        v4u nA[8]; float nbias[16];
        { const int cb = (bid * 5) & 63;
#pragma unroll
          for (int q = 0; q < 8; ++q) nA[q] = w4p[(size_t)(cb * 8 + q) * 64];
#pragma unroll
          for (int r = 0; r < 16; ++r) nbias[r] = b4[32 * cb + accrow(r, h)]; }
#pragma unroll 1
        for (int cb_ = 0; cb_ < 64; ++cb_) {
            const int cb = (cb_ + bid * 5) & 63;
            bf16x8 Ah[4], Al[4];
#pragma unroll
            for (int s_ = 0; s_ < 4; ++s_) { Ah[s_] = __builtin_bit_cast(bf16x8, nA[2 * s_]); Al[s_] = __builtin_bit_cast(bf16x8, nA[2 * s_ + 1]); }
            f32x16 acc;
#pragma unroll
            for (int r = 0; r < 16; ++r) acc[r] = nbias[r];
            { const int cbn = (cb_ + 1 + bid * 5) & 63;
#pragma unroll
              for (int q = 0; q < 8; ++q) nA[q] = w4p[(size_t)(cbn * 8 + q) * 64];
#pragma unroll
              for (int r = 0; r < 16; ++r) nbias[r] = b4[32 * cbn + accrow(r, h)]; }
            __builtin_amdgcn_sched_barrier(0);
#pragma unroll
            for (int s_ = 0; s_ < 4; ++s_) {
                acc = __builtin_amdgcn_mfma_f32_32x32x16_bf16(Al[s_], Bh[s_], acc, 0, 0, 0);
                acc = __builtin_amdgcn_mfma_f32_32x32x16_bf16(Ah[s_], Bl[s_], acc, 0, 0, 0);
                acc = __builtin_amdgcn_mfma_f32_32x32x16_bf16(Ah[s_], Bh[s_], acc, 0, 0, 0);
            }
            const bool bwd = cb >= 32;
            float sv[16];
#pragma unroll
            for (int r = 0; r < 16; ++r) {
                const int col = 32 * cb + accrow(r, h), ch = col & 1023;
                const float delta = fabsf(-3.0701134573253944f + (float)ch * ((-15.350567286626972f + 3.0701134573253944f) / 1023.0f));
                const float kv = acc[r] * __expf(-tt * delta);
                kT[(size_t)col * L + t] = kv;
                sv[r] = (bwd && t == 0) ? 0.f : fabsf(kv);
            }
#pragma unroll
            for (int k = 0; k < 8; ++k) { const bool bit = (i >> 4) & 1; const float keep = bit ? sv[k + 8] : sv[k], send = bit ? sv[k] : sv[k + 8]; sv[k] = keep + __shfl_xor(send, 16); }
#pragma unroll
            for (int k = 0; k < 4; ++k) { const bool bit = (i >> 3) & 1; const float keep = bit ? sv[k + 4] : sv[k], send = bit ? sv[k] : sv[k + 4]; sv[k] = keep + __shfl_xor(send, 8); }
#pragma unroll
            for (int k = 0; k < 2; ++k) { const bool bit = (i >> 2) & 1; const float keep = bit ? sv[k + 2] : sv[k], send = bit ? sv[k] : sv[k + 2]; sv[k] = keep + __shfl_xor(send, 4); }
            { const bool bit = (i >> 1) & 1; const float keep = bit ? sv[1] : sv[0], send = bit ? sv[0] : sv[1]; sv[0] = keep + __shfl_xor(send, 2); }
            sv[0] += __shfl_xor(sv[0], 1);
            if (do_norm && (i & 1) == 0) unsafeAtomicAdd(nrm + 32 * cb + accrow((i >> 1) & 15, h), sv[0]);
        }
    }
}

constexpr int FFT_LDS_BYTES = (FFTN + FFTN / 16) * 8, FFT_TW_OFF = FFT_LDS_BYTES;
static_assert(FFT_TW_OFF + 192 * 8 <= LDS_CTLW, "FFT LDS map");
#define FA(i) ((i) + (((i) >> 6) << 2))
__device__ __forceinline__ void fft_tables(LAS f32x2* twh, LAS f32x2* twl, int tid) {
    if (tid < 64) { float s, c; sincospif(2.0f * (float)(tid * 128) / (float)FFTN, &s, &c); twh[tid] = (f32x2){c, -s}; }
    else if (tid < 192) { const int j = tid - 64; float s, c; sincospif(2.0f * (float)j / (float)FFTN, &s, &c); twl[j] = (f32x2){c, -s}; }
}
__device__ __forceinline__ f32x2 cmul(f32x2 a, f32x2 b) { return (f32x2){a.x * b.x - a.y * b.y, a.x * b.y + a.y * b.x}; }
__device__ __forceinline__ f32x2 cmulc(f32x2 a, f32x2 b) { return (f32x2){a.x * b.x + a.y * b.y, a.y * b.x - a.x * b.y}; }
__device__ __forceinline__ f32x2 twid(const LAS f32x2* twh, const LAS f32x2* twl, int j) { return cmul(twh[j >> 7], twl[j & 127]); }
__device__ __forceinline__ int brev14(int f) { return (int)(__brev((unsigned)f) >> 18); }
#define C16_C 0.92387953251128674f
#define C16_S 0.38268343236508977f
#define RH 0.70710678118654752f
__device__ __forceinline__ f32x2 c16(int jj) { switch (jj) { case 0: return (f32x2){1.f, 0.f}; case 1: return (f32x2){C16_C, -C16_S}; case 2: return (f32x2){RH, -RH}; case 3: return (f32x2){C16_S, -C16_C};
    case 4: return (f32x2){0.f, -1.f}; case 5: return (f32x2){-C16_S, -C16_C}; case 6: return (f32x2){-RH, -RH}; default: return (f32x2){-C16_C, -C16_S}; } }
__device__ __forceinline__ void r16_fwd(f32x2 (&v)[16], f32x2 t1) {
    const f32x2 t2 = cmul(t1, t1), t4 = cmul(t2, t2), t8 = cmul(t4, t4);
#pragma unroll
    for (int jj = 0; jj < 8; ++jj) { const f32x2 w = cmul(t1, c16(jj)); const f32x2 a = v[jj], c = v[jj + 8]; v[jj] = a + c; v[jj + 8] = cmul(a - c, w); }
#pragma unroll
    for (int jj = 0; jj < 4; ++jj) { const f32x2 w = cmul(t2, c16(2 * jj));
#pragma unroll
        for (int b = 0; b < 16; b += 8) { const f32x2 a = v[b + jj], c = v[b + jj + 4]; v[b + jj] = a + c; v[b + jj + 4] = cmul(a - c, w); } }
#pragma unroll
    for (int jj = 0; jj < 2; ++jj) { const f32x2 w = cmul(t4, c16(4 * jj));
#pragma unroll
        for (int b = 0; b < 16; b += 4) { const f32x2 a = v[b + jj], c = v[b + jj + 2]; v[b + jj] = a + c; v[b + jj + 2] = cmul(a - c, w); } }
#pragma unroll
    for (int b = 0; b < 16; b += 2) { const f32x2 a = v[b], c = v[b + 1]; v[b] = a + c; v[b + 1] = cmul(a - c, t8); }
}
__device__ __forceinline__ void r16_inv(f32x2 (&v)[16], f32x2 t1) {
    const f32x2 t2 = cmul(t1, t1), t4 = cmul(t2, t2), t8 = cmul(t4, t4);
#pragma unroll
    for (int b = 0; b < 16; b += 2) { const f32x2 a = v[b], c = cmulc(v[b + 1], t8); v[b] = a + c; v[b + 1] = a - c; }
#pragma unroll
    for (int jj = 0; jj < 2; ++jj) { const f32x2 w = cmul(t4, c16(4 * jj));
#pragma unroll
        for (int b = 0; b < 16; b += 4) { const f32x2 a = v[b + jj], c = cmulc(v[b + jj + 2], w); v[b + jj] = a + c; v[b + jj + 2] = a - c; } }
#pragma unroll
    for (int jj = 0; jj < 4; ++jj) { const f32x2 w = cmul(t2, c16(2 * jj));
#pragma unroll
        for (int b = 0; b < 16; b += 8) { const f32x2 a = v[b + jj], c = cmulc(v[b + jj + 4], w); v[b + jj] = a + c; v[b + jj + 4] = a - c; } }
#pragma unroll
    for (int jj = 0; jj < 8; ++jj) { const f32x2 w = cmul(t1, c16(jj)); const f32x2 a = v[jj], c = cmulc(v[jj + 8], w); v[jj] = a + c; v[jj + 8] = a - c; }
}
__device__ __forceinline__ void fft_store_p1(LAS f32x2* x, const f32x2 (&v)[16], int b) {
#pragma unroll
    for (int j = 0; j < 16; ++j) x[FA(b + 1024 * j)] = v[j];
}
__device__ __forceinline__ void fft_fwd_tail(LAS f32x2* x, const LAS f32x2* twh, const LAS f32x2* twl, int tid) {
    __syncthreads();
#pragma unroll
    for (int g = tid; g < 1024; g += 512) { const int hi = g >> 6, lo = g & 63, base = hi * 1024 + lo; f32x2 v[16];
#pragma unroll
        for (int j = 0; j < 16; ++j) v[j] = x[FA(base + 64 * j)];
        r16_fwd(v, twid(twh, twl, lo * 16));
#pragma unroll
        for (int j = 0; j < 16; ++j) x[FA(base + 64 * j)] = v[j]; }
    __syncthreads();
#pragma unroll
    for (int g = tid; g < 1024; g += 512) { const int hi = g >> 2, lo = g & 3, base = hi * 64 + lo; f32x2 v[16];
#pragma unroll
        for (int j = 0; j < 16; ++j) v[j] = x[FA(base + 4 * j)];
        r16_fwd(v, twid(twh, twl, lo * 256));
#pragma unroll
        for (int j = 0; j < 16; ++j) x[FA(base + 4 * j)] = v[j]; }
    __syncthreads();
#pragma unroll 2
    for (int g = tid; g < 4096; g += 512) { LAS f32x4* p = (LAS f32x4*)(x + FA(4 * g)); const f32x4 u0 = p[0], u1 = p[1];
        f32x2 v0 = {u0.x, u0.y}, v1 = {u0.z, u0.w}, v2 = {u1.x, u1.y}, v3 = {u1.z, u1.w};
        const f32x2 a0 = v0 + v2, a2 = v0 - v2, a1 = v1 + v3, d = v1 - v3, a3 = (f32x2){d.y, -d.x};
        v0 = a0 + a1; v1 = a0 - a1; v2 = a2 + a3; v3 = a2 - a3;
        p[0] = (f32x4){v0.x, v0.y, v1.x, v1.y}; p[1] = (f32x4){v2.x, v2.y, v3.x, v3.y}; }
    __syncthreads();
}
__device__ __forceinline__ void fft_inv_head(LAS f32x2* x, const LAS f32x2* twh, const LAS f32x2* twl, int tid) {
#pragma unroll 2
    for (int g = tid; g < 4096; g += 512) { LAS f32x4* p = (LAS f32x4*)(x + FA(4 * g)); const f32x4 u0 = p[0], u1 = p[1];
        f32x2 v0 = {u0.x, u0.y}, v1 = {u0.z, u0.w}, v2 = {u1.x, u1.y}, v3 = {u1.z, u1.w};
        const f32x2 a0 = v0 + v1, a1 = v0 - v1, a2 = v2 + v3, d = v2 - v3, a3 = (f32x2){-d.y, d.x};
        v0 = a0 + a2; v2 = a0 - a2; v1 = a1 + a3; v3 = a1 - a3;
        p[0] = (f32x4){v0.x, v0.y, v1.x, v1.y}; p[1] = (f32x4){v2.x, v2.y, v3.x, v3.y}; }
    __syncthreads();
#pragma unroll
    for (int g = tid; g < 1024; g += 512) { const int hi = g >> 2, lo = g & 3, base = hi * 64 + lo; f32x2 v[16];
#pragma unroll
        for (int j = 0; j < 16; ++j) v[j] = x[FA(base + 4 * j)];
        r16_inv(v, twid(twh, twl, lo * 256));
#pragma unroll
        for (int j = 0; j < 16; ++j) x[FA(base + 4 * j)] = v[j]; }
    __syncthreads();
#pragma unroll
    for (int g = tid; g < 1024; g += 512) { const int hi = g >> 6, lo = g & 63, base = hi * 1024 + lo; f32x2 v[16];
#pragma unroll
        for (int j = 0; j < 16; ++j) v[j] = x[FA(base + 64 * j)];
        r16_inv(v, twid(twh, twl, lo * 16));
#pragma unroll
        for (int j = 0; j < 16; ++j) x[FA(base + 64 * j)] = v[j]; }
    __syncthreads();
}

__device__ __forceinline__ void pro_fftk(const Args& a, LAS unsigned char* lds, int bid, int nb, int tid) {
    LAS f32x2* x = (LAS f32x2*)lds; LAS f32x2* twh = (LAS f32x2*)(lds + FFT_TW_OFF); LAS f32x2* twl = twh + 64;
    fft_tables(twh, twl, tid);
    __syncthreads();
    float raw[2][16][2]; float nr[4];
#define FK_LOAD(item) do { const int l_ = (item) >> 9, p_ = (item) & 511; const float* kT_ = (const float*)(a.ws + WS_KT8) + (size_t)l_ * 2048 * SEQ; \
        const float* nrm_ = (const float*)(a.ws + WS_NORM) + (size_t)(l_ * 2) * 2048; \
        nr[0] = nrm_[2 * p_]; nr[1] = nrm_[1024 + 2 * p_]; nr[2] = nrm_[2 * p_ + 1]; nr[3] = nrm_[1024 + 2 * p_ + 1]; \
        _Pragma("unroll") for (int e = 0; e < 2; ++e) { const int b_ = tid + 512 * e; \
            _Pragma("unroll") for (int j = 0; j < 8; ++j) { raw[e][j][0] = kT_[(size_t)(2 * p_) * SEQ + b_ + 1024 * j]; raw[e][j][1] = kT_[(size_t)(2 * p_ + 1) * SEQ + b_ + 1024 * j]; } \
            _Pragma("unroll") for (int j = 8; j < 16; ++j) { int s_ = FFTN - (b_ + 1024 * j); s_ = s_ > SEQ - 1 ? SEQ - 1 : s_;            \
                raw[e][j][0] = kT_[(size_t)(1024 + 2 * p_) * SEQ + s_]; raw[e][j][1] = kT_[(size_t)(1024 + 2 * p_ + 1) * SEQ + s_]; } } } while (0)
    if (bid < DEPTH * 512) FK_LOAD(bid);
    for (int it = bid; it < DEPTH * 512; it += nb) {
        const int l = it >> 9, p = it & 511;
        const float i1 = 1.0f / (nr[0] + nr[1]), i2 = 1.0f / (nr[2] + nr[3]);
#pragma unroll
        for (int e = 0; e < 2; ++e) { const int b = tid + 512 * e; f32x2 v[16];
#pragma unroll
            for (int j = 0; j < 16; ++j) v[j] = (j >= 8 && b + 1024 * j == SEQ) ? (f32x2){0.f, 0.f} : (f32x2){raw[e][j][0] * i1, raw[e][j][1] * i2};
            r16_fwd(v, twid(twh, twl, b));
            fft_store_p1(x, v, b); }
        if (it + nb < DEPTH * 512) FK_LOAD(it + nb);
        fft_fwd_tail(x, twh, twl, tid);
        v2u* spec = (v2u*)(a.ws + WS_SPEC) + ((size_t)l * 512 + p) * SPEC_PITCH;
        const float sc = 0.5f;
        f32x2 zfv[16], znv[16];
#pragma unroll
        for (int k = 0; k < 16; ++k) { const int pp = 2 * (tid + 512 * k), f = brev14(pp), qq = brev14((FFTN - f) & (FFTN - 1)); zfv[k] = x[FA(pp)]; znv[k] = x[FA(qq)]; }
#pragma unroll
        for (int k = 0; k <= 16; ++k) {
            const int pe = tid + 512 * k; if (k == 16 && tid != 0) break;
            const int pp = k < 16 ? 2 * pe : 1, f = brev14(pp), qq = brev14((FFTN - f) & (FFTN - 1));
            const f32x2 zf = k < 16 ? zfv[k < 16 ? k : 0] : x[FA(pp)], zn = k < 16 ? znv[k < 16 ? k : 0] : x[FA(qq)];
            const f32x2 k1 = (f32x2){0.5f * (zf.x + zn.x), 0.5f * (zf.y - zn.y)};
            const f32x2 dd = (f32x2){zf.x - zn.x, zf.y + zn.y};
            const f32x2 k2 = (f32x2){0.5f * dd.y, -0.5f * dd.x};
            spec[pe] = (v2u){pack_h2((k1.x + k2.x) * sc, (k1.y + k2.y) * sc), pack_h2((k1.x - k2.x) * sc, (k1.y - k2.y) * sc)};
        }
        __syncthreads();
    }
}

__device__ __forceinline__ void ph_norm(const Args& a, int l, int s, int nslab, int gw, int ngw, int lane) {
    xh* X = (xh*)(a.ws + WS_X); bf16* U = (bf16*)(a.ws + WS_U);
    const bool in_l = (l == 0 && s == 0), in_c = (l == 0 && s <= 1);
    const float* g = a.in[I_NORMG] + ((size_t)l * 3 + s) * D;
    const bool permute = (s == 1) && (l & 1);
    const int nbk = ngw >> 3, bidk = gw >> 3, wv = gw & 7;
    const bool ctxw = wv == 0;
    if (!ctxw && !in_l) {
        const float* mod = (const float*)(a.ws + WS_MODS) + (size_t)l * 2 * NMODC + (size_t)(3 * s) * D;
        f32x4 ga[4][2], sh[4][2];
#pragma unroll
        for (int j = 0; j < 4; ++j)
#pragma unroll
            for (int h = 0; h < 2; ++h) { const int c = 8 * lane + 512 * j + 4 * h; ga[j][h] = *(const f32x4*)(g + c) * (*(const f32x4*)(mod + D + c) + 1.0f); sh[j][h] = *(const f32x4*)(mod + c); }
        const int step = nbk * 7; int r = bidk * 7 + (wv - 1);
        h8 cur[4];
        if (r < SEQ) { const int src = permute ? (r & (GRID_R - 1)) * GRID_W + (r >> 7) : r; const h8* xr = (const h8*)(X + (size_t)src * D) + lane;
#pragma unroll
            for (int j = 0; j < 4; ++j) cur[j] = xr[64 * j]; }
        while (r < SEQ) {
            const int rn = r + step, rq = rn < SEQ ? rn : r; h8 nxt[4];
            { const int src = permute ? (rq & (GRID_R - 1)) * GRID_W + (rq >> 7) : rq; const h8* xr = (const h8*)(X + (size_t)src * D) + lane;
#pragma unroll
              for (int j = 0; j < 4; ++j) nxt[j] = xr[64 * j]; }
            f32x4 v[4][2]; float ss = 0.f;
#pragma unroll
            for (int j = 0; j < 4; ++j) { v[j][0] = __builtin_convertvector(__builtin_shufflevector(cur[j], cur[j], 0, 1, 2, 3), f32x4); v[j][1] = __builtin_convertvector(__builtin_shufflevector(cur[j], cur[j], 4, 5, 6, 7), f32x4);
#pragma unroll
                for (int h = 0; h < 2; ++h) ss += (v[j][h].x * v[j][h].x + v[j][h].y * v[j][h].y) + (v[j][h].z * v[j][h].z + v[j][h].w * v[j][h].w); }
            const float rs = rsqrtf(wave_sum(ss) * (1.0f / D) + EPS);
            bf16* o = U + (size_t)r * D + 8 * lane;
#pragma unroll
            for (int j = 0; j < 4; ++j) { const f32x4 y0 = v[j][0] * rs * ga[j][0] + sh[j][0], y1 = v[j][1] * rs * ga[j][1] + sh[j][1];
                st16_wt(o + 512 * j, (v4u){pk2(y0.x, y0.y), pk2(y0.z, y0.w), pk2(y1.x, y1.y), pk2(y1.z, y1.w)}); }
#pragma unroll
            for (int j = 0; j < 4; ++j) cur[j] = nxt[j];
            r = rn;
        }
        return;
    }
    for (int r = ctxw ? SEQ + bidk : bidk * 7 + (wv - 1); r < (ctxw ? MROWS : SEQ); r += ctxw ? nbk : nbk * 7) {
        const int which = r >= SEQ ? 1 : 0;
        const float* mod = (const float*)(a.ws + WS_MODS) + ((size_t)l * 2 + which) * NMODC + (size_t)(3 * s) * D;
        int src = r; if (permute && r < SEQ) src = (r & (GRID_R - 1)) * GRID_W + (r >> 7);
        f32x4 v[8]; float ss = 0.f;
        if (which ? in_c : in_l) { const f32x4* xr = (const f32x4*)((which ? a.in[I_CTX] - (size_t)SEQ * D : a.in[I_X]) + (size_t)src * D) + lane;
#pragma unroll
            for (int j = 0; j < 8; ++j) v[j] = xr[64 * j];
            if (!which) { h4* xw = (h4*)(X + (size_t)r * D) + lane;
#pragma unroll
                for (int j = 0; j < 8; ++j) xw[64 * j] = __builtin_convertvector(v[j], h4); }
        } else { const h4* xr = (const h4*)(X + (size_t)src * D) + lane; h4 t[8];
#pragma unroll
            for (int j = 0; j < 8; ++j) t[j] = xr[64 * j];
#pragma unroll
            for (int j = 0; j < 8; ++j) v[j] = __builtin_convertvector(t[j], f32x4); }
        if (which && nslab) {
            for (int k0 = 0; k0 < nslab; k0 += 6) { h4 sv[6][8];
#pragma unroll
                for (int kk = 0; kk < 6; ++kk) { const int k = k0 + kk < nslab ? k0 + kk : nslab - 1; const h4* sr = (const h4*)((const xh*)(a.ws + WS_SLAB) + ((size_t)k * CTX + (r - SEQ)) * D) + lane;
#pragma unroll
                    for (int j = 0; j < 8; ++j) sv[kk][j] = sr[64 * j]; }
#pragma unroll
                for (int kk = 0; kk < 6; ++kk) if (k0 + kk < nslab) {
#pragma unroll
                    for (int j = 0; j < 8; ++j) v[j] += __builtin_convertvector(sv[kk][j], f32x4); } }
            h4* xw = (h4*)(X + (size_t)r * D) + lane;
#pragma unroll
            for (int j = 0; j < 8; ++j) xw[64 * j] = __builtin_convertvector(v[j], h4);
        }
#pragma unroll
        for (int j = 0; j < 8; ++j) ss += (v[j].x * v[j].x + v[j].y * v[j].y) + (v[j].z * v[j].z + v[j].w * v[j].w);
        const float rs = rsqrtf(wave_sum(ss) * (1.0f / D) + EPS);
        v2u* o = (v2u*)(U + (size_t)r * D) + lane;
#pragma unroll
        for (int j = 0; j < 8; ++j) { const int c = 4 * lane + 256 * j; const f32x4 gg = *(const f32x4*)(g + c), sh = *(const f32x4*)(mod + c), scl = *(const f32x4*)(mod + D + c);
            const f32x4 y = v[j] * rs * gg * (scl + 1.0f) + sh;
            v2u w; w.x = pk2(y.x, y.y); w.y = pk2(y.z, y.w); o[64 * j] = w; }
    }
}

__device__ __forceinline__ void ph_convs(const Args& a, int l, LAS unsigned char* lds, int bid, int nb, int tid) {
    const bf16* P = (const bf16*)(a.ws + WS_P);
    LAS float* wt = (LAS float*)lds;
    const int cl = tid & 63, rg = tid >> 6;
    for (int it = bid; it < (SEQ / 64) * 8; it += nb) {
        const int rb = it >> 3, cb = it & 7, r0 = rb * 64, c = cb * 128 + 2 * cl;
        const int lo = rb >= SEQ / 64 ? SEQ : 0, hi = rb >= SEQ / 64 ? MROWS : SEQ;
        const int rs0 = r0 + rg * 8;
        unsigned ux[11], uh[3][10];
#pragma unroll
        for (int i = 0; i < 11; ++i) { const int r = rs0 - 1 + i, rc = r < lo ? lo : (r >= hi ? hi - 1 : r); ux[i] = *(const unsigned*)(P + (size_t)rc * IN_COLS + c); }
#pragma unroll
        for (int g = 0; g < 3; ++g)
#pragma unroll
            for (int i = 0; i < 10; ++i) { const int r = rs0 - 1 + i, rc = r < lo ? lo : (r >= hi ? hi - 1 : r); uh[g][i] = *(const unsigned*)(P + (size_t)rc * IN_COLS + 2048 + g * 1024 + c); }
        { const float* cw = a.in[I_LCW] + (size_t)l * 4 * 1024; const f32x2 w0 = *(const f32x2*)(cw + c), w1 = *(const f32x2*)(cw + 1024 + c), w2 = *(const f32x2*)(cw + 2048 + c), w3 = *(const f32x2*)(cw + 3072 + c), bb = *(const f32x2*)(a.in[I_LCB] + l * 1024 + c);
          f32x2 xv[11];
#pragma unroll
          for (int i = 0; i < 11; ++i) { const int r = rs0 - 1 + i; const unsigned u = (r >= lo && r < hi) ? ux[i] : 0u; xv[i] = (f32x2){bf_lo(u), bf_hi2(u)}; }
#pragma unroll
          for (int i = 0; i < 8; ++i) { const f32x2 cv = bb + w0 * xv[i] + w1 * xv[i + 1] + w2 * xv[i + 2] + w3 * xv[i + 3];
              *(unsigned*)((bf16*)(a.ws + WS_CVB) + (size_t)(rs0 + i) * 1024 + c) = pk2(cv.x, cv.y); } }
        f32x2 z[3][8];
#pragma unroll
        for (int g = 0; g < 3; ++g) { const int col = g * 1024 + c; const float* cw = a.in[I_HCW] + (size_t)l * 3 * 3072; const f32x2 w0 = *(const f32x2*)(cw + col), w1 = *(const f32x2*)(cw + 3072 + col), w2 = *(const f32x2*)(cw + 6144 + col), bb = *(const f32x2*)(a.in[I_HCB] + l * 3072 + col);
            f32x2 xv[10];
#pragma unroll
            for (int i = 0; i < 10; ++i) { const int r = rs0 - 1 + i; const unsigned u = (r >= lo && r < hi) ? uh[g][i] : 0u; xv[i] = (f32x2){bf_lo(u), bf_hi2(u)}; }
#pragma unroll
            for (int i = 0; i < 8; ++i) z[g][i] = bb + w0 * xv[i] + w1 * xv[i + 1] + w2 * xv[i + 2]; }
#pragma unroll
        for (int i = 0; i < 8; ++i) *(unsigned*)((bf16*)(a.ws + WS_X0) + (size_t)(rs0 + i) * 1024 + c) = pk2(z[0][i].x, z[0][i].y);
        {
#pragma unroll
            for (int i = 0; i < 8; ++i) { const f32x2 w = z[2][i] * z[1][i]; wt[(2 * cl) * 65 + rg * 8 + i] = w.x; wt[(2 * cl + 1) * 65 + rg * 8 + i] = w.y; }
            __syncthreads();
            { const int c2 = tid >> 2, seg = tid & 3; const LAS float* sp = wt + c2 * 65 + seg * 16;
              if (rb >= SEQ / 64) { float* dst = (float*)(a.ws + WS_WCTX) + (size_t)(cb * 128 + c2) * CTX + (r0 - SEQ) + seg * 16;
#pragma unroll
                  for (int k = 0; k < 4; ++k) *(f32x4*)(dst + 4 * k) = (f32x4){sp[4 * k], sp[4 * k + 1], sp[4 * k + 2], sp[4 * k + 3]}; }
              else { bf16* dst = (bf16*)(a.ws + WS_WT) + (size_t)(cb * 128 + c2) * SEQ + r0 + seg * 16;
#pragma unroll
                  for (int k = 0; k < 2; ++k) *(v4u*)(dst + 8 * k) = (v4u){pk2(sp[8 * k], sp[8 * k + 1]), pk2(sp[8 * k + 2], sp[8 * k + 3]), pk2(sp[8 * k + 4], sp[8 * k + 5]), pk2(sp[8 * k + 6], sp[8 * k + 7])}; } }
            __syncthreads();
        }
    }
    for (int sub = bid; sub < (CTX / 8) * 8; sub += nb) {
        const int rbs = sub >> 3, cb = sub & 7, c = cb * 128 + 2 * cl, row = SEQ + rbs * 8 + rg;
        unsigned ux[4], uh[3][3];
#pragma unroll
        for (int i = 0; i < 4; ++i) { const int r = row - 1 + i, rc = r < SEQ ? SEQ : (r >= MROWS ? MROWS - 1 : r); ux[i] = *(const unsigned*)(P + (size_t)rc * IN_COLS + c); }
#pragma unroll
        for (int g = 0; g < 3; ++g)
#pragma unroll
            for (int i = 0; i < 3; ++i) { const int r = row - 1 + i, rc = r < SEQ ? SEQ : (r >= MROWS ? MROWS - 1 : r); uh[g][i] = *(const unsigned*)(P + (size_t)rc * IN_COLS + 2048 + g * 1024 + c); }
        { const float* cw = a.in[I_LCW] + (size_t)l * 4 * 1024; f32x2 cv = *(const f32x2*)(a.in[I_LCB] + l * 1024 + c);
#pragma unroll
          for (int i = 0; i < 4; ++i) { const int r = row - 1 + i; const unsigned u = (r >= SEQ && r < MROWS) ? ux[i] : 0u; cv += *(const f32x2*)(cw + i * 1024 + c) * (f32x2){bf_lo(u), bf_hi2(u)}; }
          *(unsigned*)((bf16*)(a.ws + WS_CVB) + (size_t)row * 1024 + c) = pk2(cv.x, cv.y); }
        f32x2 z[3];
#pragma unroll
        for (int g = 0; g < 3; ++g) { const int col = g * 1024 + c; const float* cw = a.in[I_HCW] + (size_t)l * 3 * 3072; z[g] = *(const f32x2*)(a.in[I_HCB] + l * 3072 + col);
#pragma unroll
            for (int i = 0; i < 3; ++i) { const int r = row - 1 + i; const unsigned u = (r >= SEQ && r < MROWS) ? uh[g][i] : 0u; z[g] += *(const f32x2*)(cw + i * 3072 + col) * (f32x2){bf_lo(u), bf_hi2(u)}; } }
        *(unsigned*)((bf16*)(a.ws + WS_X0) + (size_t)row * 1024 + c) = pk2(z[0].x, z[0].y);
        { const f32x2 w = z[2] * z[1]; wt[(2 * cl) * 9 + rg] = w.x; wt[(2 * cl + 1) * 9 + rg] = w.y; }
        __syncthreads();
        if (tid < 256) { const int c2 = tid >> 1, hf = tid & 1; const LAS float* sp = wt + c2 * 9 + 4 * hf;
            *(f32x4*)((float*)(a.ws + WS_WCTX) + (size_t)(cb * 128 + c2) * CTX + rbs * 8 + 4 * hf) = (f32x4){sp[0], sp[1], sp[2], sp[3]}; }
        __syncthreads();
    }
}

__device__ __forceinline__ int scan_row(int d, int q, int i) {
    if (d == 0) return q < 8 ? SEQ + 32 * q + i : 32 * (q - 8) + i;
    return q < 8 ? SEQ + CTX - 1 - (32 * q + i) : SEQ - 1 - (32 * (q - 8) + i);
}
__device__ __forceinline__ void ph_scan1(const Args& a, int bid, int nb, int tid) {
    for (int it = bid; it < 2 * NCHUNK; it += nb) {
        const int q = it % NCHUNK, d = it / NCHUNK, ch = 2 * tid;
        const unsigned* AB = (const unsigned*)(a.ws + WS_ABP) + (size_t)d * MROWS * 1024 + ch;
        v2u w[32];
#pragma unroll
        for (int i = 0; i < 32; ++i) w[i] = *(const v2u*)(AB + (size_t)scan_row(d, q, i) * 1024);
        float l0 = 0.f, l1 = 0.f, s0 = 0.f, s1 = 0.f;
#pragma unroll
        for (int i = 0; i < 32; ++i) { const float la0 = h_lo(w[i].x), la1 = h_lo(w[i].y); l0 += la0; l1 += la1; s0 = lru_step(la0, h_hi(w[i].x), s0); s1 = lru_step(la1, h_hi(w[i].y), s1); }
        *(f32x2*)((float*)(a.ws + WS_SUMA) + ((size_t)d * NCHUNK + q) * 1024 + ch) = (f32x2){__expf(l0), __expf(l1)};
        *(f32x2*)((float*)(a.ws + WS_SUMB) + ((size_t)d * NCHUNK + q) * 1024 + ch) = (f32x2){s0, s1};
    }
}
__device__ __forceinline__ void ph_scan2(const Args& a, LAS unsigned char* lds, int bid, int tid) {
    if (bid >= 32) return;
    const int lane = tid & 63, wave = tid >> 6, gi = bid * 64 + lane, d = gi >> 10, ch = gi & 1023, q0 = 33 * wave;
    const float* SA = (const float*)(a.ws + WS_SUMA) + (size_t)d * NCHUNK * 1024 + ch; const float* SB = (const float*)(a.ws + WS_SUMB) + (size_t)d * NCHUNK * 1024 + ch;
    float* CY = (float*)(a.ws + WS_CARRY) + (size_t)d * NCHUNK * 1024 + ch;
    LAS float* gA = (LAS float*)lds; LAS float* gB = gA + 512;
    float sa[33], sb[33];
#pragma unroll
    for (int k = 0; k < 33; ++k) { sa[k] = SA[(size_t)(q0 + k) * 1024]; sb[k] = SB[(size_t)(q0 + k) * 1024]; }
    float pa = 1.f, pb = 0.f;
#pragma unroll
    for (int k = 0; k < 33; ++k) { pa *= sa[k]; pb = sa[k] * pb + sb[k]; }
    gA[wave * 64 + lane] = pa; gB[wave * 64 + lane] = pb;
    __syncthreads();
    float st = 0.f;
    for (int g = 0; g < wave; ++g) st = gA[g * 64 + lane] * st + gB[g * 64 + lane];
#pragma unroll
    for (int k = 0; k < 33; ++k) { CY[(size_t)(q0 + k) * 1024] = st; st = sa[k] * st + sb[k]; }
}
__device__ __forceinline__ void ph_ctxconv(const Args& a, int l, LAS unsigned char* lds, int first, int bid, int nb, int tid) {
    if (bid < first) return;
    const int lane = tid & 63, wave = tid >> 6;
    LAS float* kk = (LAS float*)lds + wave * 768;
    LAS float* wl = kk + 512;
    const float* KTC = (const float*)(a.ws + WS_KTC) + (size_t)l * 2048 * CTX; const float* nrm = (const float*)(a.ws + WS_NORM) + (size_t)(l * 2 + 1) * 2048;
    for (int c = (bid - first) * 8 + wave; c < 1024; c += (nb - first) * 8) {
        const float inv = 1.0f / (nrm[c] + nrm[1024 + c]);
        float wr[4];
#pragma unroll
        for (int j = 0; j < 4; ++j) { const int t = lane + 64 * j; wr[j] = ((const float*)(a.ws + WS_WCTX))[(size_t)c * CTX + t];
            kk[255 + t] = KTC[(size_t)c * CTX + t] * inv; if (t > 0) kk[255 - t] = KTC[(size_t)(1024 + c) * CTX + t] * inv; wl[t] = wr[j]; }
        LDS_WAIT(); asm volatile("" ::: "memory");
        float acc[4] = {0.f, 0.f, 0.f, 0.f};
#pragma unroll 4
        for (int s4 = 0; s4 < CTX; s4 += 4) { const f32x4 w4 = *(const LAS f32x4*)(wl + s4);
#pragma unroll
            for (int q = 0; q < 4; ++q) { const float wv = w4[q];
#pragma unroll
                for (int j = 0; j < 4; ++j) acc[j] = fmaf(kk[lane + 64 * j - (s4 + q) + 255], wv, acc[j]); } }
        const float hb = a.in[I_HBIAS][l * 1024 + c];
#pragma unroll
        for (int j = 0; j < 4; ++j) ((float*)(a.ws + WS_YCTX))[(size_t)c * CTX + lane + 64 * j] = acc[j] + hb * wr[j];
        LDS_WAIT(); asm volatile("" ::: "memory");
    }
}

__device__ __forceinline__ void ph_fftconv(const Args& a, int l, LAS unsigned char* lds, int bid, int nb, int tid) {
    LAS f32x2* x = (LAS f32x2*)lds; LAS f32x2* twh = (LAS f32x2*)(lds + FFT_TW_OFF); LAS f32x2* twl = twh + 64;
    fft_tables(twh, twl, tid);
    __syncthreads();
    for (int p = bid; p < 512; p += nb) {
        const bf16* w1 = (const bf16*)(a.ws + WS_WT) + (size_t)(2 * p) * SEQ; const bf16* w2 = w1 + SEQ;
        const v2u* spec = (const v2u*)(a.ws + WS_SPEC) + ((size_t)l * 512 + p) * SPEC_PITCH;
        v2u sp[16];
#pragma unroll
        for (int k = 0; k < 16; ++k) sp[k] = spec[tid + 512 * k];
        { unsigned u1[8], u2[8];
#pragma unroll
          for (int j = 0; j < 8; ++j) { u1[j] = *(const unsigned*)(w1 + 2 * tid + 1024 * j); u2[j] = *(const unsigned*)(w2 + 2 * tid + 1024 * j); }
#pragma unroll
          for (int e = 0; e < 2; ++e) { const int b = 2 * tid + e; f32x2 v[16];
#pragma unroll
            for (int j = 0; j < 8; ++j) v[j] = e ? (f32x2){bf_hi2(u1[j]), bf_hi2(u2[j])} : (f32x2){bf_lo(u1[j]), bf_lo(u2[j])};
#pragma unroll
            for (int j = 8; j < 16; ++j) v[j] = (f32x2){0.f, 0.f};
            r16_fwd(v, twid(twh, twl, b));
            fft_store_p1(x, v, b); } }
        fft_fwd_tail(x, twh, twl, tid);
        f32x2 zfv[16], znv[16];
#pragma unroll
        for (int k = 0; k < 16; ++k) { const int pp = 2 * (tid + 512 * k), f = brev14(pp), qq = brev14((FFTN - f) & (FFTN - 1)); zfv[k] = x[FA(pp)]; znv[k] = x[FA(qq)]; }
#pragma unroll
        for (int k = 0; k <= 16; ++k) {
            const int pe = tid + 512 * k; if (k == 16 && tid != 0) break;
            const int pp = k < 16 ? 2 * pe : 1, f = brev14(pp), qq = brev14((FFTN - f) & (FFTN - 1));
            const v2u ab = k < 16 ? sp[k < 16 ? k : 0] : spec[FFTN / 2]; const f32x2 A = {h_lo(ab.x), h_hi(ab.x)}, B = {h_lo(ab.y), h_hi(ab.y)};
            const f32x2 zf = k < 16 ? zfv[k < 16 ? k : 0] : x[FA(pp)], zn = k < 16 ? znv[k < 16 ? k : 0] : x[FA(qq)];
            const f32x2 yp = cmul(A, zf) + cmulc(B, zn);
            if (qq != pp) { const f32x2 cz = (f32x2){zf.x, -zf.y};
                const f32x2 yq = cmulc(zn, A) + (f32x2){B.x * cz.x + B.y * cz.y, B.x * cz.y - B.y * cz.x}; x[FA(qq)] = yq; }
            x[FA(pp)] = yp;
        }
        __syncthreads();
        fft_inv_head(x, twh, twl, tid);
        const float hb1 = a.in[I_HBIAS][l * 1024 + 2 * p], hb2 = a.in[I_HBIAS][l * 1024 + 2 * p + 1];
        bf16* y1 = (bf16*)(a.ws + WS_YT) + (size_t)(2 * p) * SEQ; bf16* y2 = y1 + SEQ;
        { unsigned u1[8], u2[8]; f32x2 yo[2][8];
#pragma unroll
          for (int j = 0; j < 8; ++j) { u1[j] = *(const unsigned*)(w1 + 2 * tid + 1024 * j); u2[j] = *(const unsigned*)(w2 + 2 * tid + 1024 * j); }
#pragma unroll
          for (int e = 0; e < 2; ++e) { const int b = 2 * tid + e; f32x2 v[16];
#pragma unroll
            for (int j = 0; j < 16; ++j) v[j] = x[FA(b + 1024 * j)];
            r16_inv(v, twid(twh, twl, b));
#pragma unroll
            for (int j = 0; j < 8; ++j) yo[e][j] = (f32x2){v[j].x * (1.0f / FFTN) + hb1 * (e ? bf_hi2(u1[j]) : bf_lo(u1[j])), v[j].y * (1.0f / FFTN) + hb2 * (e ? bf_hi2(u2[j]) : bf_lo(u2[j]))}; }
#pragma unroll
          for (int j = 0; j < 8; ++j) { *(unsigned*)(y1 + 2 * tid + 1024 * j) = pk2(yo[0][j].x, yo[1][j].x); *(unsigned*)(y2 + 2 * tid + 1024 * j) = pk2(yo[0][j].y, yo[1][j].y); } }
        __syncthreads();
    }
}

__device__ __forceinline__ void ph_merge(const Args& a, int l, LAS unsigned char* lds, int jlo, int jhi, int jstep, int tid, int part) {
    LAS float* T = (LAS float*)lds;
    const int lane = tid & 63, wave = tid >> 6;
    const bf16* P = (const bf16*)(a.ws + WS_P); bf16* U = (bf16*)(a.ws + WS_U);
    const float* og = a.in[I_OUTG] + (size_t)l * D;
    for (int j = jlo; j < jhi; j += jstep) {
        const bool isctx = j >= SEQ / 32; const int jc = j - SEQ / 32;
        const int r0 = isctx ? SEQ + 32 * jc : 32 * j, qf = isctx ? jc : 8 + j, qb = isctx ? 7 - jc : 8 + (SEQ / 32 - 1) - j;
        v4u yv[16];
        if (part == 0) {
#pragma unroll
            for (int idx = 0; idx < 16; ++idx) yv[idx] = (v4u){0u, 0u, 0u, 0u}; }
        else if (isctx) { const float* YT = (const float*)(a.ws + WS_YCTX) + (r0 - SEQ);
#pragma unroll
            for (int idx = 0; idx < 16; ++idx) { const int v_ = idx * 8 + wave, seg = v_ & 7, c = (v_ >> 3) * 64 + lane; yv[idx] = *(const v4u*)(YT + (size_t)c * CTX + 4 * seg); } }
        else { const bf16* YT = (const bf16*)(a.ws + WS_YT) + r0;
#pragma unroll
            for (int idx = 0; idx < 16; ++idx) { const int v_ = idx * 8 + wave, seg = v_ & 7, c = (v_ >> 3) * 64 + lane; const v2u q = *(const v2u*)(YT + (size_t)c * SEQ + 4 * seg);
                yv[idx] = (v4u){q.x, q.y, 0u, 0u}; } }
        f32x4 ogl[4];
        if (part != 1) { const int ch = 2 * tid;
          float sf0, sf1, sb0, sb1;
          if (isctx) { sf0 = sf1 = sb0 = sb1 = 0.f;
              for (int q = 0; q < qf; ++q) { const f32x2 sa = *(const f32x2*)((const float*)(a.ws + WS_SUMA) + (size_t)q * 1024 + ch), sb = *(const f32x2*)((const float*)(a.ws + WS_SUMB) + (size_t)q * 1024 + ch); sf0 = sa.x * sf0 + sb.x; sf1 = sa.y * sf1 + sb.y; }
              for (int q = 0; q < qb; ++q) { const f32x2 sa = *(const f32x2*)((const float*)(a.ws + WS_SUMA) + ((size_t)NCHUNK + q) * 1024 + ch), sb = *(const f32x2*)((const float*)(a.ws + WS_SUMB) + ((size_t)NCHUNK + q) * 1024 + ch); sb0 = sa.x * sb0 + sb.x; sb1 = sa.y * sb1 + sb.y; } }
          else { const f32x2 cf = *(const f32x2*)((const float*)(a.ws + WS_CARRY) + (size_t)qf * 1024 + ch), cb = *(const f32x2*)((const float*)(a.ws + WS_CARRY) + ((size_t)NCHUNK + qb) * 1024 + ch); sf0 = cf.x; sf1 = cf.y; sb0 = cb.x; sb1 = cb.y; }
          const unsigned* ABf = (const unsigned*)(a.ws + WS_ABP) + (size_t)r0 * 1024 + ch; const unsigned* ABb = ABf + (size_t)MROWS * 1024;
#pragma unroll
          for (int k = 0; k < 4; ++k) ogl[k] = *(const f32x4*)(og + 4 * lane + 256 * k);
#pragma unroll 1
          for (int hf_ = 0; hf_ < 2; ++hf_) { v2u w[16];
#pragma unroll
              for (int i = 0; i < 16; ++i) w[i] = *(const v2u*)(ABf + (size_t)(16 * hf_ + i) * 1024);
#pragma unroll
              for (int i = 0; i < 16; ++i) { sf0 = lru_step(h_lo(w[i].x), h_hi(w[i].x), sf0); sf1 = lru_step(h_lo(w[i].y), h_hi(w[i].y), sf1); *(LAS f32x2*)(T + (16 * hf_ + i) * 1024 + ch) = (f32x2){sf0, sf1}; } }
#pragma unroll 1
          for (int hf_ = 1; hf_ >= 0; --hf_) { v2u w[16]; unsigned yrw[16];
#pragma unroll
              for (int i = 0; i < 16; ++i) { w[i] = *(const v2u*)(ABb + (size_t)(16 * hf_ + i) * 1024); yrw[i] = *(const unsigned*)(P + (size_t)(r0 + 16 * hf_ + i) * IN_COLS + 1024 + ch); }
#pragma unroll
              for (int i = 15; i >= 0; --i) { sb0 = lru_step(h_lo(w[i].x), h_hi(w[i].x), sb0); sb1 = lru_step(h_lo(w[i].y), h_hi(w[i].y), sb1);
                  LAS f32x2* tp = (LAS f32x2*)(T + (16 * hf_ + i) * 1024 + ch); const f32x2 hf = *tp;
                  *tp = (f32x2){(hf.x + sb0) * gelu_tanh_f(bf_lo(yrw[i])), (hf.y + sb1) * gelu_tanh_f(bf_hi2(yrw[i]))}; } }
        }
        __syncthreads();
        if (part != 1) { f32x4 ogv[4];
#pragma unroll
          for (int k = 0; k < 4; ++k) ogv[k] = ogl[k];
#pragma unroll
          for (int rr = 0; rr < 4; ++rr) { const int i = wave * 4 + rr; f32x4 v[4]; float ss = 0.f;
#pragma unroll
            for (int k = 0; k < 4; ++k) { v[k] = *(const LAS f32x4*)(T + i * 1024 + 4 * lane + 256 * k); ss += (v[k].x * v[k].x + v[k].y * v[k].y) + (v[k].z * v[k].z + v[k].w * v[k].w); }
            const float rs = rsqrtf(wave_sum(ss) * (1.0f / 1024.0f) + EPS);
#pragma unroll
            for (int k = 0; k < 4; ++k) { const int c = 4 * lane + 256 * k; const f32x4 y = v[k] * rs * ogv[k]; v2u w; w.x = pk2(y.x, y.y); w.y = pk2(y.z, y.w);
                *(v2u*)(U + (size_t)(r0 + i) * D + c) = w; } } }
        __syncthreads();
        f32x4 ogv2[4]; v2u xw[4][4];
        if (part != 0) {
#pragma unroll
          for (int k = 0; k < 4; ++k) ogv2[k] = *(const f32x4*)(og + 1024 + 4 * lane + 256 * k);
#pragma unroll
          for (int rr = 0; rr < 4; ++rr)
#pragma unroll
            for (int k = 0; k < 4; ++k) xw[rr][k] = *(const v2u*)((const bf16*)(a.ws + WS_X0) + (size_t)(r0 + wave * 4 + rr) * 1024 + 4 * lane + 256 * k);
        }
        if (part != 0) {
#pragma unroll
            for (int idx = 0; idx < 16; ++idx) { const int v_ = idx * 8 + wave, seg = v_ & 7, c = (v_ >> 3) * 64 + lane;
                const v4u q = yv[idx];
                const f32x4 y = isctx ? __builtin_bit_cast(f32x4, q) : (f32x4){bf_lo(q.x), bf_hi2(q.x), bf_lo(q.y), bf_hi2(q.y)};
                T[(4 * seg + 0) * 1024 + c] = y.x; T[(4 * seg + 1) * 1024 + c] = y.y; T[(4 * seg + 2) * 1024 + c] = y.z; T[(4 * seg + 3) * 1024 + c] = y.w; }
        }
        __syncthreads();
        if (part != 0) { f32x4 ogv[4];
#pragma unroll
          for (int k = 0; k < 4; ++k) ogv[k] = ogv2[k];
#pragma unroll
          for (int rr = 0; rr < 4; ++rr) { const int i = wave * 4 + rr; f32x4 v[4]; float ss = 0.f;
#pragma unroll
            for (int k = 0; k < 4; ++k) { const v2u q = xw[rr][k]; v[k] = *(const LAS f32x4*)(T + i * 1024 + 4 * lane + 256 * k) * (f32x4){bf_lo(q.x), bf_hi2(q.x), bf_lo(q.y), bf_hi2(q.y)}; ss += (v[k].x * v[k].x + v[k].y * v[k].y) + (v[k].z * v[k].z + v[k].w * v[k].w); }
            const float rs = rsqrtf(wave_sum(ss) * (1.0f / 1024.0f) + EPS);
#pragma unroll
            for (int k = 0; k < 4; ++k) { const int c = 4 * lane + 256 * k; const f32x4 y = v[k] * rs * ogv[k]; v2u w; w.x = pk2(y.x, y.y); w.y = pk2(y.z, y.w);
                *(v2u*)(U + (size_t)(r0 + i) * D + 1024 + c) = w; } } }
        __syncthreads();
    }
}

__device__ __forceinline__ void ph_final(const Args& a, int gw, int ngw, int lane) {
    const xh* X = (const xh*)(a.ws + WS_X); const float* g = a.in[I_FINALG];
    f32x4 gg[4][2];
#pragma unroll
    for (int j = 0; j < 4; ++j)
#pragma unroll
        for (int h = 0; h < 2; ++h) gg[j][h] = *(const f32x4*)(g + 8 * lane + 512 * j + 4 * h);
    int r = gw; h8 cur[4];
    if (r < SEQ) { const h8* xr = (const h8*)(X + (size_t)r * D) + lane;
#pragma unroll
        for (int j = 0; j < 4; ++j) cur[j] = xr[64 * j]; }
    while (r < SEQ) {
        const int rn = r + ngw, rq = rn < SEQ ? rn : r; h8 nxt[4];
        { const h8* xr = (const h8*)(X + (size_t)rq * D) + lane;
#pragma unroll
          for (int j = 0; j < 4; ++j) nxt[j] = xr[64 * j]; }
        f32x4 v[4][2]; float ss = 0.f;
#pragma unroll
        for (int j = 0; j < 4; ++j) { v[j][0] = __builtin_convertvector(__builtin_shufflevector(cur[j], cur[j], 0, 1, 2, 3), f32x4); v[j][1] = __builtin_convertvector(__builtin_shufflevector(cur[j], cur[j], 4, 5, 6, 7), f32x4);
#pragma unroll
            for (int h = 0; h < 2; ++h) ss += (v[j][h].x * v[j][h].x + v[j][h].y * v[j][h].y) + (v[j][h].z * v[j][h].z + v[j][h].w * v[j][h].w); }
        const float rs = rsqrtf(wave_sum(ss) * (1.0f / D) + EPS);
        float* o = a.out + (size_t)r * D + 8 * lane;
#pragma unroll
        for (int j = 0; j < 4; ++j) { *(f32x4*)(o + 512 * j) = v[j][0] * rs * gg[j][0]; *(f32x4*)(o + 512 * j + 4) = v[j][1] * rs * gg[j][1]; }
#pragma unroll
        for (int j = 0; j < 4; ++j) cur[j] = nxt[j];
        r = rn;
    }
}

__global__ void __launch_bounds__(512, 2) fwd_kernel(Args a) {
    extern __shared__ __attribute__((aligned(16))) unsigned char lds_raw[];
    LAS unsigned char* lds = (LAS unsigned char*)lds_raw;
    const int lo = a.ph_lo, hi = a.ph_hi;
#if MK_ONE_LAUNCH
    if (threadIdx.x < 16) ((LAS unsigned*)(lds + LDS_CTLW))[threadIdx.x] = 0u;
    __syncthreads();
    XcdBarrier bar = xcd_barrier_post((unsigned*)(a.ws + WS_CTL) + 4096, (volatile LAS unsigned*)(lds + LDS_CTLW));
#define GRID_BAR() xcd_barrier(bar)
#else
#define GRID_BAR() do { } while (0)
#endif
#ifndef DBG_ONLY
#define DBG_ONLY (-1)
#endif
#define EN(tag) (DBG_ONLY < 0 || DBG_ONLY == (tag))
#ifndef DBG_REP
#define DBG_REP 0
#endif
#define REP(tag) for (int rep_ = 0; rep_ < (((DBG_REP >> (tag)) & 1) ? 2 : 1); ++rep_)
#define IN(k) (lo <= (k) && (k) < hi)
#define FRESH() int tid = threadIdx.x; asm volatile("" : "+v"(tid)); const int lane = tid & 63, wave = __builtin_amdgcn_readfirstlane(tid >> 6); int bid = blockIdx.x; asm volatile("" : "+s"(bid)); const int nb = gridDim.x, gw = bid * 8 + wave, ngw = nb * 8; (void)lane; (void)gw; (void)ngw; (void)nb
#define SEAM(k) do { if (IN((k) + 1)) GRID_BAR(); } while (0)

    if (IN(PH_PRO0)) {
        FRESH();
        REP(0) if (EN(0)) pro_weights(a, lds, gw, ngw, wave, lane);
        for (int i = bid * 512 + tid; i < DEPTH * 2 * 1024; i += nb * 512) ((float*)(a.ws + WS_SP8))[i] = 8.0f * log1pf(expf(-a.in[I_LAM][i]));
        __syncthreads();
        pro_w4p(a, bid * 512 + tid, nb * 512);
        SEAM(PH_PRO0);
    }
    if (EN(2) && IN(PH_PRO1)) { FRESH();
        { LAS float* sl = (LAS float*)lds; LAS float* sc = sl + D;
          for (int i = tid; i < D; i += 512) { sl[i] = silu_f(a.in[I_C][i]); sc[i] = silu_f(a.in[I_CCTX][i]); }
          __syncthreads();
          if (wave >= 5) pro_mods_wave(a, sl, sc, (wave - 5) * nb + bid, 3 * nb + (nb - 32), lane);
          else if (wave == 4 && bid >= 32) pro_mods_wave(a, sl, sc, 3 * nb + (bid - 32), 3 * nb + (nb - 32), lane); }
        pro_filters(a, bid, nb, wave, lane, true);
        SEAM(PH_PRO1); }
    if (EN(3) && IN(PH_PRO2)) { FRESH(); __syncthreads(); REP(3) pro_fftk(a, lds, bid, nb, tid); SEAM(PH_PRO2); }

    for (int st = 0; st < DEPTH * 3; ++st) {
        int l = st / 3; const int kind = st % 3;
        const int base = PH_LAYER0 + PH_PER_LAYER * l + (kind == 0 ? 0 : kind == 1 ? 3 : 11);
        if (base >= hi || base + 8 <= lo) continue;
        const float* mods_l = (const float*)(a.ws + WS_MODS) + (size_t)l * 2 * NMODC; const float* mods_c = mods_l + NMODC;
        if (EN(4) && IN(base)) { FRESH(); REP(4) ph_norm(a, l, kind, rep_ ? 0 : (kind == 2 ? (l == DEPTH - 1 ? 0 : 8) : (kind == 0 && l == 0 ? 0 : 11)), gw, ngw, lane); SEAM(base); }
        if (kind != 1) {
            const int f = kind >> 1;
            if (EN(5) && IN(base + 1)) { FRESH();
                pg8::Gemm g{(const bf16*)(a.ws + WS_U), (const bf16*)(a.ws + WS_WUP) + (size_t)(l * 2 + f) * 2 * DFF * D, MROWS, 2 * DFF, D, D, D, 1 << 20, 0, 1 << 20, 0};
                pg8::StaticOrder S; S.init(MROWS, 2 * DFF, nb, bid, 1);
                unsigned* cnt = (unsigned*)(a.ws + WS_CTL + 32768) + 64 * (l * 2 + f);
                const bool need_ctx = !(l == DEPTH - 1 && kind == 2);
                EpiSwiGLU E{(bf16*)(a.ws + WS_H), cnt};
                pg8::gemm_phase<EpiSwiGLU>(lds, g, S, E);
                { const int ublk = S.nwg % nb;
                  if (ublk > 0 && bid >= ublk) {
                      if (need_ctx) {
                          if (tid == 0) { XB_SPIN(xb_ld(cnt) < 44u * 8u, (unsigned*)(a.ws + WS_CTL) + 4096); __builtin_amdgcn_fence(__ATOMIC_ACQUIRE, "agent"); asm volatile("s_waitcnt vmcnt(0)" ::: "memory"); }
                          __syncthreads();
                          pg8::Gemm g2{(const bf16*)(a.ws + WS_H) + (size_t)SEQ * DFF, (const bf16*)(a.ws + WS_WDN) + (size_t)(l * 2 + f) * D * DFF, CTX, D * 11, 512, DFF, DFF, 8, 512, 8, 512};
                          pg8::StaticOrder S2; S2.init(CTX, D * 11, nb - ublk, bid - ublk);
                          EpiSlab E2{(xh*)(a.ws + WS_SLAB), mods_c + (size_t)(3 * kind + 2) * D, 0.5f, 8};
                          pg8::gemm_phase<EpiSlab>(lds, g2, S2, E2);
                      }
                      if (l + 1 < DEPTH && bid >= ublk + 4) conv_range(a, lds, l + 1, kind == 0 ? CONV_T0 : CONV_T3, kind == 0 ? CONV_T1 : CONV_T4, (bid - ublk - 4) * 8 + wave, (nb - ublk - 4) * 8, wave, lane); } }
                SEAM(base + 1);
            }
            if (EN(6) && IN(base + 2)) { FRESH();
                { pg8::Gemm g{(const bf16*)(a.ws + WS_H), (const bf16*)(a.ws + WS_WDN) + (size_t)(l * 2 + f) * D * DFF, SEQ, D, DFF, DFF, DFF, 1 << 20, 0, 1 << 20, 0};
                  pg8::StaticOrder S; S.init(SEQ, D, nb, bid);
                  REP(6) { EpiResid E{(xh*)(a.ws + WS_X), mods_l + (size_t)(3 * kind + 2) * D, (((DBG_REP >> 6) & 1) && rep_ == 0) ? 0.0f : 0.5f, 0};
                  pg8::gemm_phase<EpiResid>(lds, g, S, E); } }
                SEAM(base + 2);
            }
        } else {
            if (EN(7) && IN(base + 1)) { FRESH();
                pg8::Gemm g{(const bf16*)(a.ws + WS_U), (const bf16*)(a.ws + WS_WIN) + (size_t)l * IN_COLS * D, MROWS, IN_COLS, D, D, D, 1 << 20, 0, 1 << 20, 0};
                pg8::StaticOrder S; S.init(MROWS, IN_COLS, nb, bid);
                EpiBf16Out E{(bf16*)(a.ws + WS_P), IN_COLS};
                REP(7) pg8::gemm_phase<EpiBf16Out>(lds, g, S, E);
                { const int ublk = S.nwg % nb;
                  if (l + 1 < DEPTH && ublk > 0 && bid >= ublk) conv_range(a, lds, l + 1, CONV_T1, CONV_T2, (bid - ublk) * 8 + wave, (nb - ublk) * 8, wave, lane); }
                SEAM(base + 1);
            }
            if (EN(8) && IN(base + 2)) { FRESH(); REP(8) ph_convs(a, l, lds, bid, nb, tid); SEAM(base + 2); }
            if (EN(9) && IN(base + 3)) { FRESH();
                pg8::Gemm g{(const bf16*)(a.ws + WS_CVB), (const bf16*)(a.ws + WS_WLRU) + (size_t)l * 4096 * 256, MROWS, 4096, 256, 1024, 256, 4, 256, 1 << 20, 0};
                pg8::StaticOrder S; S.init(MROWS, 4096, nb, bid);
                EpiGates E{a.in[I_BA] + (size_t)l * 2048, a.in[I_BX] + (size_t)l * 2048, (const float*)(a.ws + WS_SP8) + (size_t)l * 2048, (const bf16*)(a.ws + WS_CVB), (unsigned*)(a.ws + WS_ABP)};
                REP(9) pg8::gemm_phase<EpiGates>(lds, g, S, E);
                REP(15) ph_ctxconv(a, l, lds, 16, bid, nb, tid);
                SEAM(base + 3);
            }
            if (IN(base + 4)) { FRESH(); if (EN(10)) { REP(10) ph_scan1(a, bid, nb, tid); } __syncthreads(); if (EN(12)) { REP(12) ph_fftconv(a, l, lds, bid, nb, tid); } SEAM(base + 4); }
            if (EN(11) && IN(base + 5)) { FRESH(); REP(11) { ph_scan2(a, lds, bid, tid); if (bid >= 32 && bid < 48) { const int jc = (bid - 32) >> 1; ph_merge(a, l, lds, SEQ / 32 + jc, SEQ / 32 + jc + 1, 1, tid, (bid - 32) & 1); } __syncthreads(); }
                if (l + 1 < DEPTH && bid >= 48) conv_range(a, lds, l + 1, CONV_T2, CONV_T3, (bid - 48) * 8 + wave, (nb - 48) * 8, wave, lane);
                SEAM(base + 5); }
            if (EN(13) && IN(base + 6)) { FRESH(); __syncthreads(); REP(13) ph_merge(a, l, lds, bid, SEQ / 32, nb, tid, 2); SEAM(base + 6); }
            if (EN(14) && IN(base + 7)) { FRESH();
                { pg8::Gemm g{(const bf16*)(a.ws + WS_U), (const bf16*)(a.ws + WS_WOUT) + (size_t)l * D * D, SEQ, D, D, D, D, 1 << 20, 0, 1 << 20, 0};
                  pg8::StaticOrder S; S.init(SEQ, D, nb, bid);
                  REP(14) { EpiResid E{(xh*)(a.ws + WS_X), mods_l + (size_t)5 * D, (((DBG_REP >> 14) & 1) && rep_ == 0) ? 0.0f : 1.0f, l & 1};
                  pg8::gemm_phase<EpiResid>(lds, g, S, E); } }
                {
                  pg8::Gemm g{(const bf16*)(a.ws + WS_U) + (size_t)SEQ * D, (const bf16*)(a.ws + WS_WOUT) + (size_t)l * D * D, CTX, D * 8, 256, D, D, 8, 256, 8, 256};
                  pg8::StaticOrder S; S.init(CTX, D * 8, nb, bid);
                  EpiSlab E{(xh*)(a.ws + WS_SLAB), mods_c + (size_t)5 * D, 1.0f, 8};
                  REP(14) if (l != DEPTH - 1) pg8::gemm_phase<EpiSlab>(lds, g, S, E);
                  if (l + 1 < DEPTH && bid >= 64) conv_range(a, lds, l + 1, CONV_T5, CONV_T6, (bid - 64) * 8 + wave, (nb - 64) * 8, wave, lane); }
                SEAM(base + 7);
            }
        }
    }
    if (EN(15) && IN(PH_FINAL)) { FRESH(); ph_final(a, gw, ngw, lane); }
#undef IN
#undef SEAM
}

extern "C" void kernel_launch(void* const* d_in, const int* in_sizes, int n_in, void* d_out, int out_size, void* d_ws, size_t ws_size, hipStream_t stream) {
    static int grid = 0;
    if (grid == 0) {
        if (n_in != N_IN || out_size != SEQ * D || ws_size < WS_END) { fprintf(stderr, "kernel_launch: unexpected shapes (n_in %d, out %d, ws %zu < %zu); nothing launched\n", n_in, out_size, ws_size, (size_t)WS_END); grid = -1; return; }
        int dev = 0, cus = 0, per_cu = 0;
        if (hipGetDevice(&dev) != hipSuccess || hipDeviceGetAttribute(&cus, hipDeviceAttributeMultiprocessorCount, dev) != hipSuccess) { grid = -1; return; }
        if (hipFuncSetAttribute((const void*)fwd_kernel, hipFuncAttributeMaxDynamicSharedMemorySize, LDS_BYTES) != hipSuccess) { fprintf(stderr, "kernel_launch: hipFuncSetAttribute failed\n"); grid = -1; return; }
        if (hipOccupancyMaxActiveBlocksPerMultiprocessor(&per_cu, (const void*)fwd_kernel, 512, LDS_BYTES) != hipSuccess || per_cu < 1) fprintf(stderr, "kernel_launch: occupancy query says %d blocks per CU\n", per_cu);
        (void)hipGetLastError();
        grid = cus;
    }
    if (grid < 0) return;
    (void)in_sizes;
    Args a{};
    for (int i = 0; i < N_IN; ++i) a.in[i] = (const float*)d_in[i];
    a.out = (float*)d_out; a.ws = (unsigned char*)d_ws;
    (void)hipMemsetAsync((char*)d_ws + WS_CTL, 0, 131072, stream);
#if MK_ONE_LAUNCH
    a.ph_lo = 0; a.ph_hi = N_PHASES;
    hipLaunchKernelGGL(fwd_kernel, dim3(grid), dim3(512), LDS_BYTES, stream, a);
#else
    for (int ph = 0; ph < N_PHASES; ++ph) { a.ph_lo = ph; a.ph_hi = ph + 1; hipLaunchKernelGGL(fwd_kernel, dim3(grid), dim3(512), LDS_BYTES, stream, a); }
#endif
}
```
